# Optimizing an MI355X kernel written in HIP

```python
import jax, jax.numpy as jnp
from jax import lax
import numpy as np


D_MODEL = 1024
BATCH = 8
SEQ = 2048
DEPTH = 1
DEC_BATCH = 128
DEC_SEQ = 1
PAST_LEN = 16384
PAGE_SIZE = 128

MAMBA_D_INNER = 2 * D_MODEL
MAMBA_HEAD_DIM = 64
MAMBA_N_HEADS = MAMBA_D_INNER // MAMBA_HEAD_DIM
MAMBA_N_GROUPS = 8
MAMBA_HEADS_PER_GROUP = MAMBA_N_HEADS // MAMBA_N_GROUPS
MAMBA_D_STATE = 128
MAMBA_CONV_DIM = MAMBA_D_INNER + 2 * MAMBA_N_GROUPS * MAMBA_D_STATE
CONV_WIDTH = 4
MLSTM_D_INNER = D_MODEL
MLSTM_N_HEADS = 8
MLSTM_HEAD_DIM = MLSTM_D_INNER // MLSTM_N_HEADS
D_FF = 4 * D_MODEL
CHUNK = 128
EPS = 1e-6
IN_WIDTH = (MAMBA_D_INNER + MAMBA_CONV_DIM + MAMBA_N_HEADS + 3 * MLSTM_D_INNER
            + 2 * MLSTM_N_HEADS + 2 * D_MODEL)

kernel_name = 'hybrid_ssd_mlstm_gated_decoder_step'


def _split_points():
    sizes = (MAMBA_D_INNER, MAMBA_CONV_DIM, MAMBA_N_HEADS, MLSTM_D_INNER, MLSTM_D_INNER,
             MLSTM_D_INNER, MLSTM_N_HEADS, MLSTM_N_HEADS, D_MODEL, D_MODEL)
    pts, acc = [], 0
    for s in sizes[:-1]:
        acc += s
        pts.append(acc)
    return pts


def rmsnorm(x, w):
    xf = x.astype(jnp.float32)
    y = xf * lax.rsqrt(jnp.mean(xf * xf, axis=-1, keepdims=True) + EPS)
    return (y * w.astype(jnp.float32)).astype(x.dtype)


def causal_conv(x, buf, w, b):
    T = x.shape[1]
    xp = jnp.concatenate([buf.astype(x.dtype), x], axis=1)
    y = b
    for j in range(CONV_WIDTH):
        y = y + xp[:, j:j + T] * w[j]
    return y, xp[:, -(CONV_WIDTH - 1):]


def _chunk_setup(T):
    L = min(CHUNK, T)
    nc = -(-T // L)
    return L, nc * L


def _pad_t(a, Tp, value=0.0):
    pad = Tp - a.shape[1]
    return jnp.pad(a, [(0, 0), (0, pad)] + [(0, 0)] * (a.ndim - 2), constant_values=value)


def _to_chunks(a, L):
    return jnp.moveaxis(a.reshape((a.shape[0], a.shape[1] // L, L) + a.shape[2:]), 1, 0)


def _from_chunks(a):
    a = jnp.moveaxis(a, 0, 1)
    return a.reshape((a.shape[0], a.shape[1] * a.shape[2]) + a.shape[3:])


def ssd_scan(x, dt, A, Bm, Cm, h0):
    f32 = jnp.float32
    Bsz, T = x.shape[:2]
    G, R, P, N = MAMBA_N_GROUPS, MAMBA_HEADS_PER_GROUP, MAMBA_HEAD_DIM, MAMBA_D_STATE
    L, Tp = _chunk_setup(T)
    xs = _to_chunks(_pad_t(x.astype(f32), Tp).reshape(Bsz, Tp, G, R, P), L)
    dts = _to_chunks(_pad_t(dt.astype(f32), Tp).reshape(Bsz, Tp, G, R), L)
    Bs = _to_chunks(_pad_t(Bm.astype(f32), Tp), L)
    Cs = _to_chunks(_pad_t(Cm.astype(f32), Tp), L)
    A_gj = A.astype(f32).reshape(G, R)
    causal = jnp.tril(jnp.ones((L, L), dtype=bool))

    def step(h, inp):
        xc, dtc, Bc, Cc = inp
        acum = jnp.cumsum(dtc * A_gj, axis=1)
        seg = acum[:, :, None] - acum[:, None, :]
        decay = jnp.exp(jnp.where(causal[None, :, :, None, None], seg, -jnp.inf))
        cb = jnp.einsum('bsgn,brgn->bsrg', Cc, Bc)
        wgt = cb[..., None] * decay * dtc[:, None]
        y = jnp.einsum('bsrgj,brgjp->bsgjp', wgt, xc)
        y = y + jnp.exp(acum)[..., None] * jnp.einsum('bsgn,bgjpn->bsgjp', Cc, h)
        last = acum[:, -1]
        wr = jnp.exp(last[:, None] - acum) * dtc
        h = jnp.exp(last)[..., None, None] * h + jnp.einsum('brgj,brgjp,brgn->bgjpn', wr, xc, Bc)
        return h, y

    h, ys = lax.scan(step, h0.astype(f32).reshape(Bsz, G, R, P, N), (xs, dts, Bs, Cs))
    y = _from_chunks(ys)[:, :T].reshape(Bsz, T, MAMBA_N_HEADS, P)
    return y, h.reshape(Bsz, MAMBA_N_HEADS, P, N)


def mlstm_scan(q, k, v, ig, logf, C0, n0, m0):
    f32 = jnp.float32
    Bsz, T = q.shape[:2]
    L, Tp = _chunk_setup(T)
    qs = _to_chunks(_pad_t(q.astype(f32), Tp), L)
    ks = _to_chunks(_pad_t(k.astype(f32), Tp), L)
    vs = _to_chunks(_pad_t(v.astype(f32), Tp), L)
    igs = _to_chunks(_pad_t(ig.astype(f32), Tp, -1e30), L)
    lfs = _to_chunks(_pad_t(logf.astype(f32), Tp), L)
    causal = jnp.tril(jnp.ones((L, L), dtype=bool))

    def step(carry, inp):
        C, n, m = carry
        qc, kc, vc, ic, fc = inp
        bcum = jnp.cumsum(fc, axis=1)
        logD = bcum[:, :, None] - bcum[:, None, :] + ic[:, None, :]
        logD = jnp.where(causal[None, :, :, None], logD, -jnp.inf)
        inter = bcum + m[:, None]
        m_s = jnp.maximum(inter, jnp.max(logD, axis=2))
        Dm = jnp.exp(logD - m_s[:, :, None])
        sc = jnp.exp(inter - m_s)
        wgt = jnp.einsum('bshd,brhd->bsrh', qc, kc) * Dm
        num = jnp.einsum('bsrh,brhe->bshe', wgt, vc) + sc[..., None] * jnp.einsum('bshd,bhde->bshe', qc, C)
        den = jnp.sum(wgt, axis=2) + sc * jnp.einsum('bshd,bhd->bsh', qc, n)
        h = num / jnp.maximum(jnp.abs(den), jnp.exp(-m_s))[..., None]
        bl = bcum[:, -1]
        src = bl[:, None] - bcum + ic
        m_new = jnp.maximum(bl + m, jnp.max(src, axis=1))
        wr = jnp.exp(src - m_new[:, None])
        keep = jnp.exp(bl + m - m_new)
        C = keep[..., None, None] * C + jnp.einsum('brh,brhd,brhe->bhde', wr, kc, vc)
        n = keep[..., None] * n + jnp.einsum('brh,brhd->bhd', wr, kc)
        return (C, n, m_new), h

    (C, n, m), hs = lax.scan(step, (C0.astype(f32), n0.astype(f32), m0.astype(f32)), (qs, ks, vs, igs, lfs))
    return _from_chunks(hs)[:, :T], C, n, m


def mixer(xn, st, p):
    (w_in, m_cw, m_cb, dt_bias, A_log, Dskip, m_nw, w_a,
     l_cw, l_cb, wq, wk, i_b, f_b, l_nw, w_b, w_o) = p
    conv_m, ssm0, conv_l, C0, n0, m0 = st
    Bsz, T, _ = xn.shape
    dtype = xn.dtype
    f32 = jnp.float32
    proj = xn @ w_in
    z, xbc, dt_raw, u, v, o_pre, i_pre, f_pre, g_a, g_b = jnp.split(proj, _split_points(), axis=-1)

    xbc, conv_m_new = causal_conv(xbc, conv_m, m_cw, m_cb)
    xbc = jax.nn.silu(xbc)
    xm, Bm, Cm = jnp.split(xbc, [MAMBA_D_INNER, MAMBA_D_INNER + MAMBA_N_GROUPS * MAMBA_D_STATE], axis=-1)
    xm = xm.reshape(Bsz, T, MAMBA_N_HEADS, MAMBA_HEAD_DIM)
    Bm = Bm.reshape(Bsz, T, MAMBA_N_GROUPS, MAMBA_D_STATE)
    Cm = Cm.reshape(Bsz, T, MAMBA_N_GROUPS, MAMBA_D_STATE)
    dt = jax.nn.softplus(dt_raw.astype(f32) + dt_bias.astype(f32))
    A = -jnp.exp(A_log.astype(f32))
    ya, ssm_new = ssd_scan(xm, dt, A, Bm, Cm, ssm0)
    ya = (ya + Dskip.astype(f32)[:, None] * xm.astype(f32)).astype(dtype)
    ya = ya.reshape(Bsz, T, MAMBA_D_INNER) * jax.nn.silu(z)
    ya = rmsnorm(ya.reshape(Bsz, T, MAMBA_N_GROUPS, -1), m_nw.reshape(MAMBA_N_GROUPS, -1))
    y_a = ya.reshape(Bsz, T, MAMBA_D_INNER) @ w_a

    uc, conv_l_new = causal_conv(u, conv_l, l_cw, l_cb)
    uc = jax.nn.silu(uc).reshape(Bsz, T, MLSTM_N_HEADS, MLSTM_HEAD_DIM)
    q = jnp.einsum('bthd,hde->bthe', uc, wq)
    k = jnp.einsum('bthd,hde->bthe', uc, wk) * (MLSTM_HEAD_DIM ** -0.5)
    vh = v.reshape(Bsz, T, MLSTM_N_HEADS, MLSTM_HEAD_DIM)
    ig = i_pre.astype(f32) + i_b.astype(f32)
    logf = jax.nn.log_sigmoid(f_pre.astype(f32) + f_b.astype(f32))
    hb, C_new, n_new, m_new = mlstm_scan(q, k, vh, ig, logf, C0, n0, m0)
    hb = rmsnorm(hb.astype(dtype), l_nw.reshape(MLSTM_N_HEADS, MLSTM_HEAD_DIM))
    hb = jax.nn.sigmoid(o_pre) * hb.reshape(Bsz, T, MLSTM_D_INNER)
    y_b = hb @ w_b

    out = (jax.nn.sigmoid(g_a) * y_a + jax.nn.sigmoid(g_b) * y_b) @ w_o
    new_st = (conv_m_new.astype(dtype), ssm_new.astype(dtype), conv_l_new.astype(dtype),
              C_new.astype(dtype), n_new.astype(dtype), m_new.astype(dtype))
    return out, new_st


def block(x, st, p, norm_mix_w, norm_mlp_w, w_up, w_down):
    mix, new_st = mixer(rmsnorm(x, norm_mix_w), st, p)
    x = x + mix
    h = rmsnorm(x, norm_mlp_w)
    x = x + jnp.square(jax.nn.relu(h @ w_up)) @ w_down
    return x, new_st


def setup_inputs(seed: int = 0) -> dict:
    key = jax.random.key(seed)
    ks = jax.random.split(key, 40)
    f32 = jnp.float32

    def nrm(k, shape, scale):
        return jax.random.normal(k, shape, f32) * scale

    Dd = DEPTH
    dt0 = jnp.exp(jax.random.uniform(ks[12], (Dd, MAMBA_N_HEADS), f32, np.log(1e-3), np.log(1e-1)))
    return {
        'x_prompt': nrm(ks[0], (BATCH, SEQ, D_MODEL), 1.0),
        'x_sample': nrm(ks[1], (DEC_BATCH, DEC_SEQ, D_MODEL), 1.0),
        'state_mamba_conv': nrm(ks[2], (Dd, DEC_BATCH, CONV_WIDTH - 1, MAMBA_CONV_DIM), 1.0),
        'state_mamba_ssm': nrm(ks[3], (Dd, DEC_BATCH, MAMBA_N_HEADS, MAMBA_HEAD_DIM, MAMBA_D_STATE), 0.1),
        'state_mlstm_conv': nrm(ks[4], (Dd, DEC_BATCH, CONV_WIDTH - 1, MLSTM_D_INNER), 1.0),
        'state_mlstm_C': nrm(ks[5], (Dd, DEC_BATCH, MLSTM_N_HEADS, MLSTM_HEAD_DIM, MLSTM_HEAD_DIM), 0.1),
        'state_mlstm_n': nrm(ks[6], (Dd, DEC_BATCH, MLSTM_N_HEADS, MLSTM_HEAD_DIM), 0.1),
        'state_mlstm_m': nrm(ks[7], (Dd, DEC_BATCH, MLSTM_N_HEADS), 1.0),
        'w_in': nrm(ks[8], (Dd, D_MODEL, IN_WIDTH), D_MODEL ** -0.5),
        'mamba_conv_w': nrm(ks[9], (Dd, CONV_WIDTH, MAMBA_CONV_DIM), 0.5),
        'mamba_conv_b': nrm(ks[10], (Dd, MAMBA_CONV_DIM), 0.02),
        'mamba_dt_bias': dt0 + jnp.log(-jnp.expm1(-dt0)),
        'mamba_A_log': jnp.log(jax.random.uniform(ks[11], (Dd, MAMBA_N_HEADS), f32, 1.0, 16.0)),
        'mamba_D': 1.0 + nrm(ks[13], (Dd, MAMBA_N_HEADS), 0.02),
        'mamba_norm_w': 1.0 + nrm(ks[14], (Dd, MAMBA_D_INNER), 0.02),
        'w_branch_a': nrm(ks[15], (Dd, MAMBA_D_INNER, D_MODEL), MAMBA_D_INNER ** -0.5),
        'mlstm_conv_w': nrm(ks[16], (Dd, CONV_WIDTH, MLSTM_D_INNER), 0.5),
        'mlstm_conv_b': nrm(ks[17], (Dd, MLSTM_D_INNER), 0.02),
        'mlstm_wq': nrm(ks[18], (Dd, MLSTM_N_HEADS, MLSTM_HEAD_DIM, MLSTM_HEAD_DIM), MLSTM_HEAD_DIM ** -0.5),
        'mlstm_wk': nrm(ks[19], (Dd, MLSTM_N_HEADS, MLSTM_HEAD_DIM, MLSTM_HEAD_DIM), MLSTM_HEAD_DIM ** -0.5),
        'mlstm_i_bias': nrm(ks[20], (Dd, MLSTM_N_HEADS), 0.1),
        'mlstm_f_bias': 3.0 + jax.random.uniform(ks[21], (Dd, MLSTM_N_HEADS), f32, 0.0, 3.0),
        'mlstm_norm_w': 1.0 + nrm(ks[22], (Dd, MLSTM_D_INNER), 0.02),
        'w_branch_b': nrm(ks[23], (Dd, MLSTM_D_INNER, D_MODEL), MLSTM_D_INNER ** -0.5),
        'w_out': nrm(ks[24], (Dd, D_MODEL, D_MODEL), D_MODEL ** -0.5),
        'norm_mix_w': 1.0 + nrm(ks[25], (Dd, D_MODEL), 0.02),
        'norm_mlp_w': 1.0 + nrm(ks[26], (Dd, D_MODEL), 0.02),
        'w_up': nrm(ks[27], (Dd, D_MODEL, D_FF), D_MODEL ** -0.5),
        'w_down': nrm(ks[28], (Dd, D_FF, D_MODEL), D_FF ** -0.5),
        'final_norm_w': 1.0 + nrm(ks[29], (D_MODEL,), 0.02),
    }


def reference(x_prompt, x_sample, state_mamba_conv, state_mamba_ssm, state_mlstm_conv,
              state_mlstm_C, state_mlstm_n, state_mlstm_m, w_in, mamba_conv_w, mamba_conv_b,
              mamba_dt_bias, mamba_A_log, mamba_D, mamba_norm_w, w_branch_a, mlstm_conv_w,
              mlstm_conv_b, mlstm_wq, mlstm_wk, mlstm_i_bias, mlstm_f_bias, mlstm_norm_w,
              w_branch_b, w_out, norm_mix_w, norm_mlp_w, w_up, w_down, final_norm_w):
    dtype = x_prompt.dtype
    Bp = x_prompt.shape[0]
    zero_state = (
        jnp.zeros((Bp, CONV_WIDTH - 1, MAMBA_CONV_DIM), dtype),
        jnp.zeros((Bp, MAMBA_N_HEADS, MAMBA_HEAD_DIM, MAMBA_D_STATE), dtype),
        jnp.zeros((Bp, CONV_WIDTH - 1, MLSTM_D_INNER), dtype),
        jnp.zeros((Bp, MLSTM_N_HEADS, MLSTM_HEAD_DIM, MLSTM_HEAD_DIM), dtype),
        jnp.zeros((Bp, MLSTM_N_HEADS, MLSTM_HEAD_DIM), dtype),
        jnp.zeros((Bp, MLSTM_N_HEADS), dtype),
    )
    xp, xs = x_prompt, x_sample
    p_states, s_states = [], []
    for l in range(DEPTH):
        p = (w_in[l], mamba_conv_w[l], mamba_conv_b[l], mamba_dt_bias[l], mamba_A_log[l], mamba_D[l],
             mamba_norm_w[l], w_branch_a[l], mlstm_conv_w[l], mlstm_conv_b[l], mlstm_wq[l], mlstm_wk[l],
             mlstm_i_bias[l], mlstm_f_bias[l], mlstm_norm_w[l], w_branch_b[l], w_out[l])
        s_in = (state_mamba_conv[l], state_mamba_ssm[l], state_mlstm_conv[l],
                state_mlstm_C[l], state_mlstm_n[l], state_mlstm_m[l])
        xp, st_p = block(xp, zero_state, p, norm_mix_w[l], norm_mlp_w[l], w_up[l], w_down[l])
        xs, st_s = block(xs, s_in, p, norm_mix_w[l], norm_mlp_w[l], w_up[l], w_down[l])
        p_states.append(st_p)
        s_states.append(st_s)
    y_prompt = rmsnorm(xp, final_norm_w)
    y_sample = rmsnorm(xs, final_norm_w)
    ps = [jnp.stack(z, axis=0) for z in zip(*p_states)]
    ss = [jnp.stack(z, axis=0) for z in zip(*s_states)]
    return (y_prompt, y_sample, ps[0], ps[1], ps[2], ps[3], ps[4], ps[5],
            ss[0], ss[1], ss[2], ss[3], ss[4], ss[5])
```

```cpp
#include <hip/hip_runtime.h>
#include <hip/hip_cooperative_groups.h>
#include <cstdio>
namespace cg = cooperative_groups;

#define LAS __attribute__((address_space(3)))
typedef unsigned short bf16_t;
typedef short bf16x8 __attribute__((ext_vector_type(8)));
typedef float f32x4 __attribute__((ext_vector_type(4)));
typedef unsigned u32x4 __attribute__((ext_vector_type(4)));
typedef unsigned u32x2 __attribute__((ext_vector_type(2)));
typedef float f32x2v __attribute__((ext_vector_type(2)));

constexpr int DM = 1024, TSEQ = 2048, NBATCH = 8, NSAMP = 128;
constexpr int MP = NBATCH * TSEQ;
constexpr int MR = MP + NSAMP;
constexpr int MPAD = 16640;
constexpr int LDP = 11520;
constexpr int Z_OFF = 0, XBC_OFF = 2048, U_OFF = 6144, V_OFF = 7168, O_OFF = 8192, GA_OFF = 9216, GB_OFF = 10240, G_OFF = 11264;
constexpr int DFF = 4096;
constexpr float EPS = 1e-6f;
constexpr size_t OFF_Y = 0;
constexpr size_t OFF_P_MCONV = (size_t)MR * 1024;
constexpr size_t OFF_P_SSM = OFF_P_MCONV + 8 * 3 * 4096;
constexpr size_t OFF_P_LCONV = OFF_P_SSM + (size_t)8 * 32 * 64 * 128;
constexpr size_t OFF_P_C = OFF_P_LCONV + 8 * 3 * 1024;
constexpr size_t OFF_P_N = OFF_P_C + (size_t)8 * 8 * 128 * 128;
constexpr size_t OFF_P_M = OFF_P_N + 8 * 8 * 128;
constexpr size_t OFF_S_MCONV = OFF_P_M + 64;
constexpr size_t OFF_S_SSM = OFF_S_MCONV + (size_t)128 * 3 * 4096;
constexpr size_t OFF_S_LCONV = OFF_S_SSM + (size_t)128 * 32 * 64 * 128;
constexpr size_t OFF_S_C = OFF_S_LCONV + (size_t)128 * 3 * 1024;
constexpr size_t OFF_S_N = OFF_S_C + (size_t)128 * 8 * 128 * 128;
constexpr size_t OFF_S_M = OFF_S_N + (size_t)128 * 8 * 128;
constexpr size_t WS_WIN = 0;
constexpr size_t WS_WA = WS_WIN + (size_t)LDP * 1024 * 2;
constexpr size_t WS_WB = WS_WA + (size_t)1024 * 2048 * 2;
constexpr size_t WS_WO = WS_WB + (size_t)1024 * 1024 * 2;
constexpr size_t WS_WUP = WS_WO + (size_t)1024 * 1024 * 2;
constexpr size_t WS_WDN = WS_WUP + (size_t)4096 * 1024 * 2;
constexpr size_t WS_WQ = WS_WDN + (size_t)4096 * 1024 * 2;
constexpr size_t WS_WK = WS_WQ + (size_t)8 * 128 * 128 * 2;
constexpr size_t WS_XN = WS_WK + (size_t)8 * 128 * 128 * 2;
constexpr size_t WS_PROJ = WS_XN + (size_t)MPAD * 1024 * 2;
constexpr size_t WS_GATES = WS_PROJ + (size_t)MPAD * LDP * 2;
constexpr size_t WS_GSSQ = WS_GATES + (size_t)MPAD * 64 * 4;
constexpr size_t WS_SSQ = WS_GSSQ + (size_t)MP * 32 * 4;
constexpr size_t WS_MRG = WS_SSQ + (size_t)MPAD * 16 * 4;
constexpr size_t WS_BAR = WS_MRG + (size_t)MPAD * 1024 * 2;
constexpr size_t WS_PCNT = WS_BAR + 16384;
constexpr size_t WS_PX = WS_PCNT + 32768;
constexpr size_t WS_END = WS_PX + (size_t)MP * 4 * 4;

__device__ __forceinline__ size_t pidx(size_t row, int col) { return ((size_t)(col >> 6) * MPAD + row) * 64 + (col & 63); }
struct Params {
    const float *x_prompt, *x_sample, *st_mconv, *st_ssm, *st_lconv, *st_C, *st_n, *st_m;
    const float *w_in, *m_cw, *m_cb, *dt_bias, *A_log, *Dskip, *m_nw, *w_a, *l_cw, *l_cb, *wq, *wk, *i_b, *f_b, *l_nw, *w_b, *w_o, *nmix, *nmlp, *w_up, *w_down, *fnw;
    float* out;
    unsigned char* ws;
};

typedef __bf16 bf16v2_t __attribute__((ext_vector_type(2)));
__device__ __forceinline__ unsigned cvt_pk_bf16(float lo, float hi) { bf16v2_t v; v[0] = (__bf16)lo; v[1] = (__bf16)hi; return __builtin_bit_cast(unsigned, v); }
__device__ __forceinline__ bf16_t f2bf(float f) { return __builtin_bit_cast(bf16_t, (__bf16)f); }
__device__ __forceinline__ float bf2f(bf16_t b) { return __uint_as_float(((unsigned)b) << 16); }
__device__ __forceinline__ float bflo(unsigned w) { return __uint_as_float(w << 16); }
__device__ __forceinline__ float bfhi(unsigned w) { return __uint_as_float(w & 0xffff0000u); }
__device__ __forceinline__ float sigm(float x) { return __builtin_amdgcn_rcpf(1.f + __expf(-x)); }
__device__ __forceinline__ float silu(float x) { return x * __builtin_amdgcn_rcpf(1.f + __expf(-x)); }
__device__ __forceinline__ float softplus(float x) { return fmaxf(x, 0.f) + __logf(1.f + __expf(-fabsf(x))); }
__device__ __forceinline__ float logsigm(float x) { return fminf(x, 0.f) - __logf(1.f + __expf(-fabsf(x))); }
__device__ __forceinline__ float wave_sum(float v) {
#pragma unroll
    for (int o = 1; o < 64; o <<= 1) v += __shfl_xor(v, o);
    return v;
}

namespace pg8 {
constexpr int BM = 256, BK = 64, HALF = 128, HTB = HALF * BK * 2, STAGE_BYTES = 8 * HTB, NXCD = 8, WGM = 8;
__host__ __device__ __forceinline__ int lds_byte(int r, int c) { const int st = (r >> 4) * 2 + (c >> 5), rr = r & 15, cc = c & 31, ob = rr * 64 + cc * 2; return st * 1024 + (ob ^ (((ob >> 9) & 1) << 5)); }
__host__ __device__ __forceinline__ void stage_rc(int b, int& R, int& C) { const int st = b / 1024, sb = b % 1024, swz = sb ^ (((sb >> 9) & 1) << 5); R = (st >> 1) * 16 + swz / 64; C = (st & 1) * 32 + (swz % 64) / 2; }
__host__ __device__ __forceinline__ int perm32(int rho) { const int n = rho >> 4, i = rho & 15; return 8 * (i >> 2) + 4 * n + (i & 3); }
struct Unit { int pm, pn; };
struct StaticOrder {
    int nM, nN, nwg, G, c;
    __device__ void init(int M, int N, int G_, int c_) { nM = M / BM; nN = N / BM; nwg = nM * nN; G = G_; c = c_; }
    __device__ bool next(int i, Unit& u) const {
        const long L = (long)i * G + c; if (L >= nwg) return false;
        int wgid = (int)L; { const int q = nwg / NXCD, r = nwg % NXCD, xcd = wgid % NXCD, off = wgid / NXCD; wgid = (xcd < r ? xcd * (q + 1) : r * (q + 1) + (xcd - r) * q) + off; }
        const int nig = WGM * nN, gid = wgid / nig, fm = gid * WGM, gsz = (nM - fm) < WGM ? (nM - fm) : WGM;
        u.pm = fm + ((wgid % nig) % gsz); u.pn = (wgid % nig) / gsz; return true;
    }
};

template <class Epi>
__device__ __forceinline__ void gemm_phase(LAS unsigned char* lds, const bf16_t* A, int lda, const bf16_t* Bt, int K, const StaticOrder& S, const Epi& E) {
    int tid_ = threadIdx.x; asm volatile("" : "+v"(tid_));
    const int tid = tid_, wid = __builtin_amdgcn_readfirstlane(tid >> 6), lane = tid & 63, wr = wid >> 2, wc = wid & 3, fr = lane & 15, fq = lane >> 4;
    const int nt = K / BK;
    unsigned voffA[2], voffB[2];
#pragma unroll
    for (int i = 0; i < 2; ++i) { int R, C; stage_rc(tid * 16 + i * 8192, R, C); const int Rb = Epi::PERM ? ((R & ~31) + perm32(R & 31)) : R;
        voffA[i] = (unsigned)(R * lda + C) * 2u; voffB[i] = (unsigned)(Rb * K + C) * 2u; }
    const size_t kstep = (size_t)(BK * 2);
    const size_t hstepA = (size_t)HALF * lda * 2, hstepB = (size_t)HALF * K * 2;
    const size_t tstepA = 2 * hstepA, tstepB = 2 * hstepB;
    const unsigned ldsw = (unsigned)wid * 1024u;
    const int aoff = lds_byte(wr * 64 + fr, fq * 8), boff = lds_byte(wc * 32 + fr, fq * 8);
#define PG8_SA(b, h) (((b) * 2 + (h)) * HTB)
#define PG8_SB(b, h) ((4 + (b) * 2 + (h)) * HTB)
#define PG8_STAGE(bufoff, gbase, voff) do { _Pragma("unroll") for (int _i = 0; _i < 2; ++_i) \
        __builtin_amdgcn_global_load_lds((const unsigned*)((const char*)(gbase) + (voff)[_i]), (LAS unsigned*)(lds + (bufoff) + ldsw + _i * 8192), 16, 0, 0); } while (0)
#define PG8_LDA(dst, b, h) do { _Pragma("unroll") for (int m = 0; m < 4; ++m) _Pragma("unroll") for (int k = 0; k < 2; ++k) dst[m][k] = *(const LAS bf16x8*)(lds + PG8_SA(b, h) + aoff + m * 2048 + k * 1024); } while (0)
#define PG8_LDB(dst, b, h) do { _Pragma("unroll") for (int n = 0; n < 2; ++n) _Pragma("unroll") for (int k = 0; k < 2; ++k) dst[n][k] = *(const LAS bf16x8*)(lds + PG8_SB(b, h) + boff + n * 2048 + k * 1024); } while (0)
#define PG8_MMA(ai, bj, At, Bt_) do { __builtin_amdgcn_s_setprio(1); _Pragma("unroll") for (int m = 0; m < 4; ++m) _Pragma("unroll") for (int n = 0; n < 2; ++n) _Pragma("unroll") for (int k = 0; k < 2; ++k) \
        acc[ai][bj][m][n] = __builtin_amdgcn_mfma_f32_16x16x32_bf16(Bt_[n][k], At[m][k], acc[ai][bj][m][n], 0, 0, 0); __builtin_amdgcn_s_setprio(0); } while (0)
#define PG8_WAIT_V(n) asm volatile("s_waitcnt vmcnt(" #n ")" ::: "memory")
#define PG8_WAIT_L(n) asm volatile("s_waitcnt lgkmcnt(" #n ")" ::: "memory")
#define PG8_BAR __builtin_amdgcn_s_barrier()
#define PG8_SCHED __builtin_amdgcn_sched_barrier(0)
    Unit cur, nxt; int ui = 0;
    if (!S.next(0, cur)) return;
    f32x4 acc[2][2][4][2];
#pragma unroll
    for (int a = 0; a < 2; ++a)
#pragma unroll
        for (int b = 0; b < 2; ++b)
#pragma unroll
            for (int m = 0; m < 4; ++m)
#pragma unroll
                for (int n = 0; n < 2; ++n) acc[a][b][m][n] = (f32x4){0.f, 0.f, 0.f, 0.f};
    bf16x8 At[4][2], B0[2][2], B1[2][2];
    const char* cA = (const char*)A + (size_t)cur.pm * tstepA; const char* cB = (const char*)Bt + (size_t)cur.pn * tstepB;
    PG8_STAGE(PG8_SB(0, 0), cB, voffB); PG8_STAGE(PG8_SA(0, 0), cA, voffA); PG8_STAGE(PG8_SB(0, 1), cB + hstepB, voffB); PG8_STAGE(PG8_SA(0, 1), cA + hstepA, voffA);
    if (wr == 1) PG8_BAR;
    PG8_WAIT_V(4); PG8_BAR;
    PG8_STAGE(PG8_SB(1, 0), cB + kstep, voffB); PG8_STAGE(PG8_SA(1, 0), cA + kstep, voffA); PG8_STAGE(PG8_SB(1, 1), cB + hstepB + kstep, voffB);
    PG8_WAIT_V(6); PG8_BAR;
    for (;;) {
        const bool has_next = Epi::GSCALE ? false : S.next(ui + 1, nxt);
        const char* nA = has_next ? (const char*)A + (size_t)nxt.pm * tstepA : cA; const char* nB = has_next ? (const char*)Bt + (size_t)nxt.pn * tstepB : cB;
        for (int t = 0; t < nt; t += 2) {
            if constexpr (Epi::GSCALE) { if (t > 0 && (t & 3) == 0) { E.gscale(acc, lds, t >> 2, wr, fr); PG8_SCHED; } }
            const bool last = (t == nt - 2);
            const char* a1 = cA + (size_t)(t + 1) * kstep;
            const char* a2 = last ? nA : cA + (size_t)(t + 2) * kstep; const char* b2 = last ? nB : cB + (size_t)(t + 2) * kstep;
            const char* a3 = a2 + kstep; const char* b3 = b2 + kstep;
            PG8_LDB(B0, 0, 0); PG8_SCHED; PG8_LDA(At, 0, 0); PG8_STAGE(PG8_SA(1, 1), a1 + hstepA, voffA);
            PG8_WAIT_L(8); PG8_BAR; PG8_WAIT_L(0); PG8_MMA(0, 0, At, B0); PG8_BAR; PG8_SCHED;
            PG8_LDB(B1, 0, 1); PG8_STAGE(PG8_SB(0, 0), b2, voffB);
            PG8_BAR; PG8_WAIT_L(0); PG8_MMA(0, 1, At, B1); PG8_BAR;
            PG8_LDA(At, 0, 1); PG8_STAGE(PG8_SA(0, 0), a2, voffA);
            PG8_BAR; PG8_WAIT_L(0); PG8_MMA(1, 0, At, B0); PG8_BAR; PG8_SCHED;
            PG8_STAGE(PG8_SB(0, 1), b2 + hstepB, voffB);
            PG8_WAIT_V(6); PG8_BAR; PG8_MMA(1, 1, At, B1); PG8_BAR;
            PG8_LDB(B0, 1, 0); PG8_SCHED; PG8_LDA(At, 1, 0); PG8_STAGE(PG8_SA(0, 1), a2 + hstepA, voffA);
            PG8_WAIT_L(8); PG8_BAR; PG8_WAIT_L(0); PG8_MMA(0, 0, At, B0); PG8_BAR; PG8_SCHED;
            PG8_LDB(B1, 1, 1); PG8_STAGE(PG8_SB(1, 0), b3, voffB);
            PG8_BAR; PG8_WAIT_L(0); PG8_MMA(0, 1, At, B1); PG8_BAR;
            PG8_LDA(At, 1, 1); PG8_STAGE(PG8_SA(1, 0), a3, voffA);
            PG8_BAR; PG8_WAIT_L(0); PG8_MMA(1, 0, At, B0); PG8_BAR; PG8_SCHED;
            PG8_STAGE(PG8_SB(1, 1), b3 + hstepB, voffB);
            PG8_WAIT_V(6); PG8_BAR; PG8_MMA(1, 1, At, B1); PG8_BAR;
        }
        if constexpr (!Epi::AFTER_DRAIN) E(acc, cur, wr, wc, fr, fq);
        if (!has_next) break;
#pragma unroll
        for (int a = 0; a < 2; ++a)
#pragma unroll
            for (int b = 0; b < 2; ++b)
#pragma unroll
                for (int m = 0; m < 4; ++m)
#pragma unroll
                    for (int n = 0; n < 2; ++n) acc[a][b][m][n] = (f32x4){0.f, 0.f, 0.f, 0.f};
        cur = nxt; cA = nA; cB = nB; ++ui;
    }
    PG8_WAIT_V(0);
    if (wr == 0) PG8_BAR;
    PG8_BAR;
    if constexpr (Epi::AFTER_DRAIN) E.fused(acc, cur, wr, wc, fr, fq, lds, wid, lane);
#undef PG8_SA
#undef PG8_SB
#undef PG8_STAGE
#undef PG8_LDA
#undef PG8_LDB
#undef PG8_MMA
#undef PG8_WAIT_V
#undef PG8_WAIT_L
#undef PG8_BAR
#undef PG8_SCHED
}
}
using pg8::Unit;

struct EpiProj {
    static constexpr bool PERM = true, AFTER_DRAIN = false, GSCALE = false;
    bf16_t* proj; float* gates; float* out;
    __device__ __forceinline__ void operator()(const f32x4 (&acc)[2][2][4][2], const Unit& u, int wr, int wc, int fr, int fq) const {
        const int colt = u.pn * 256 + wc * 32 + 8 * fq;
#pragma unroll
        for (int ai = 0; ai < 2; ++ai)
#pragma unroll
            for (int m = 0; m < 4; ++m) {
                const int row = u.pm * 256 + ai * 128 + wr * 64 + m * 16 + fr;
                int srow = -1; bool samp = false;
                if (row < MP) { const int t = row & (TSEQ - 1); if (t >= TSEQ - 3) srow = (row >> 11) * 3 + (t - (TSEQ - 3)); }
                else if (row < MR) { srow = (row - MP) * 3 + 2; samp = true; }
#pragma unroll
                for (int bj = 0; bj < 2; ++bj) {
                    const int col = colt + bj * 128;
                    const f32x4 v0 = acc[ai][bj][m][0], v1 = acc[ai][bj][m][1];
                    u32x4 w; w.x = cvt_pk_bf16(v0[0], v0[1]); w.y = cvt_pk_bf16(v0[2], v0[3]); w.z = cvt_pk_bf16(v1[0], v1[1]); w.w = cvt_pk_bf16(v1[2], v1[3]);
                    __builtin_nontemporal_store(w, (u32x4*)(proj + pidx(row, col)));
                    if (u.pn == 44 && bj == 0 && wc < 2) { float* g = gates + (size_t)row * 64 + wc * 32 + 8 * fq; *(f32x4*)g = v0; *(f32x4*)(g + 4) = v1; }
                    if (srow >= 0 && col >= XBC_OFF && col < V_OFF) {
                        float* d;
                        if (col < U_OFF) d = out + (samp ? OFF_S_MCONV : OFF_P_MCONV) + (size_t)srow * 4096 + (col - XBC_OFF);
                        else d = out + (samp ? OFF_S_LCONV : OFF_P_LCONV) + (size_t)srow * 1024 + (col - U_OFF);
                        *(f32x4*)d = v0; *(f32x4*)(d + 4) = v1;
                    }
                }
            }
    }
};
struct EpiGateA {
    static constexpr bool PERM = true, AFTER_DRAIN = false, GSCALE = false;
    bf16_t* proj;
    __device__ __forceinline__ void operator()(const f32x4 (&acc)[2][2][4][2], const Unit& u, int wr, int wc, int fr, int fq) const {
        const int colt = u.pn * 256 + wc * 32 + 8 * fq;
#pragma unroll
        for (int ai = 0; ai < 2; ++ai)
#pragma unroll
            for (int m = 0; m < 4; ++m) {
                const int row = u.pm * 256 + ai * 128 + wr * 64 + m * 16 + fr;
                if (row < MR) {
#pragma unroll
                    for (int bj = 0; bj < 2; ++bj) {
                        const int col = colt + bj * 128;
                        const u32x4 g = __builtin_nontemporal_load((const u32x4*)(proj + pidx(row, GA_OFF + col)));
                        const f32x4 a0 = acc[ai][bj][m][0], a1 = acc[ai][bj][m][1];
                        f32x4 o0, o1;
                        o0[0] = sigm(bflo(g.x)) * a0[0]; o0[1] = sigm(bfhi(g.x)) * a0[1]; o0[2] = sigm(bflo(g.y)) * a0[2]; o0[3] = sigm(bfhi(g.y)) * a0[3];
                        o1[0] = sigm(bflo(g.z)) * a1[0]; o1[1] = sigm(bfhi(g.z)) * a1[1]; o1[2] = sigm(bflo(g.w)) * a1[2]; o1[3] = sigm(bfhi(g.w)) * a1[3];
                        float* d = (float*)(proj + (size_t)(XBC_OFF / 64) * MPAD * 64) + (size_t)row * 1024 + col;
                        *(f32x4*)d = o0; *(f32x4*)(d + 4) = o1;
                    }
                }
            }
    }
};
constexpr int L_RHO = 131072;
struct EpiGateAS {
    static constexpr bool PERM = true, AFTER_DRAIN = false, GSCALE = true;
    bf16_t* proj; LAS unsigned char* lds;
    __device__ __forceinline__ void gscale(f32x4 (&acc)[2][2][4][2], LAS unsigned char* lds, int g, int wr, int fr) const {
        const LAS float* rho = (const LAS float*)(lds + L_RHO);
#pragma unroll
        for (int ai = 0; ai < 2; ++ai)
#pragma unroll
            for (int m = 0; m < 4; ++m) { const float r = rho[(ai * 128 + wr * 64 + m * 16 + fr) * 8 + g];
#pragma unroll
                for (int bj = 0; bj < 2; ++bj)
#pragma unroll
                    for (int n = 0; n < 2; ++n) acc[ai][bj][m][n] *= r;
                __builtin_amdgcn_sched_barrier(0); }
    }
    __device__ __forceinline__ void operator()(const f32x4 (&acc)[2][2][4][2], const Unit& u, int wr, int wc, int fr, int fq) const {
        const int colt = u.pn * 256 + wc * 32 + 8 * fq;
#pragma unroll
        for (int ai = 0; ai < 2; ++ai)
#pragma unroll
            for (int m = 0; m < 4; ++m) {
                const int row = u.pm * 256 + ai * 128 + wr * 64 + m * 16 + fr;
                const float rsl = ((const LAS float*)(lds + L_RHO))[(ai * 128 + wr * 64 + m * 16 + fr) * 8];
                if (row < MR) {
#pragma unroll
                    for (int bj = 0; bj < 2; ++bj) {
                        const int col = colt + bj * 128;
                        const u32x4 g = __builtin_nontemporal_load((const u32x4*)(proj + pidx(row, GA_OFF + col)));
                        const f32x4 a0 = acc[ai][bj][m][0] * rsl, a1 = acc[ai][bj][m][1] * rsl;
                        f32x4 o0, o1;
                        o0[0] = sigm(bflo(g.x)) * a0[0]; o0[1] = sigm(bfhi(g.x)) * a0[1]; o0[2] = sigm(bflo(g.y)) * a0[2]; o0[3] = sigm(bfhi(g.y)) * a0[3];
                        o1[0] = sigm(bflo(g.z)) * a1[0]; o1[1] = sigm(bfhi(g.z)) * a1[1]; o1[2] = sigm(bflo(g.w)) * a1[2]; o1[3] = sigm(bfhi(g.w)) * a1[3];
                        u32x4 tw; tw.x = cvt_pk_bf16(o0[0], o0[1]); tw.y = cvt_pk_bf16(o0[2], o0[3]); tw.z = cvt_pk_bf16(o1[0], o1[1]); tw.w = cvt_pk_bf16(o1[2], o1[3]);
                        *(u32x4*)(proj + (size_t)(XBC_OFF / 64) * MPAD * 64 + (size_t)row * 1024 + col) = tw;
                    }
                }
            }
    }
};
struct EpiGateB {
    static constexpr bool PERM = true, AFTER_DRAIN = false, GSCALE = false;
    const bf16_t* proj; bf16_t* merged;
    __device__ __forceinline__ void operator()(const f32x4 (&acc)[2][2][4][2], const Unit& u, int wr, int wc, int fr, int fq) const {
        const int colt = u.pn * 256 + wc * 32 + 8 * fq;
#pragma unroll
        for (int ai = 0; ai < 2; ++ai)
#pragma unroll
            for (int m = 0; m < 4; ++m) {
                const int row = u.pm * 256 + ai * 128 + wr * 64 + m * 16 + fr;
#pragma unroll
                for (int bj = 0; bj < 2; ++bj) {
                    const int col = colt + bj * 128;
                    f32x4 o0 = (f32x4){0.f, 0.f, 0.f, 0.f}, o1 = o0;
                    if (row < MR) {
                        const u32x4 g = __builtin_nontemporal_load((const u32x4*)(proj + pidx(row, GB_OFF + col)));
                        const u32x4 tw = *(const u32x4*)(proj + (size_t)(XBC_OFF / 64) * MPAD * 64 + (size_t)row * 1024 + col);
                        const f32x4 t0 = (f32x4){bflo(tw.x), bfhi(tw.x), bflo(tw.y), bfhi(tw.y)}, t1 = (f32x4){bflo(tw.z), bfhi(tw.z), bflo(tw.w), bfhi(tw.w)};
                        const f32x4 a0 = acc[ai][bj][m][0], a1 = acc[ai][bj][m][1];
                        o0[0] = t0[0] + sigm(bflo(g.x)) * a0[0]; o0[1] = t0[1] + sigm(bfhi(g.x)) * a0[1]; o0[2] = t0[2] + sigm(bflo(g.y)) * a0[2]; o0[3] = t0[3] + sigm(bfhi(g.y)) * a0[3];
                        o1[0] = t1[0] + sigm(bflo(g.z)) * a1[0]; o1[1] = t1[1] + sigm(bfhi(g.z)) * a1[1]; o1[2] = t1[2] + sigm(bflo(g.w)) * a1[2]; o1[3] = t1[3] + sigm(bfhi(g.w)) * a1[3];
                    }
                    u32x4 w; w.x = cvt_pk_bf16(o0[0], o0[1]); w.y = cvt_pk_bf16(o0[2], o0[3]); w.z = cvt_pk_bf16(o1[0], o1[1]); w.w = cvt_pk_bf16(o1[2], o1[3]);
                    *(u32x4*)(merged + (size_t)row * 1024 + col) = w;
                }
            }
    }
};
struct EpiResid {
    static constexpr bool PERM = false, AFTER_DRAIN = false, GSCALE = false;
    const float* xp; const float* xs;
    float* out; float* ssq;
    __device__ __forceinline__ void operator()(const f32x4 (&acc)[2][2][4][2], const Unit& u, int wr, int wc, int fr, int fq) const {
        const int colt = u.pn * 256 + wc * 32 + 4 * fq;
#pragma unroll
        for (int ai = 0; ai < 2; ++ai)
#pragma unroll
            for (int m = 0; m < 4; ++m) {
                const int row = u.pm * 256 + ai * 128 + wr * 64 + m * 16 + fr;
                float ss = 0.f;
                if (row < MR) {
                    const float* base = (row < MP) ? xp + (size_t)row * 1024 : xs + (size_t)(row - MP) * 1024;
                    float* orow = out + (size_t)row * 1024;
#pragma unroll
                    for (int bj = 0; bj < 2; ++bj)
#pragma unroll
                        for (int n = 0; n < 2; ++n) {
                            const int col = colt + bj * 128 + n * 16;
                            const f32x4 o = *(const f32x4*)(base + col) + acc[ai][bj][m][n];
                            *(f32x4*)(orow + col) = o;
                            ss += (o[0] * o[0] + o[1] * o[1]) + (o[2] * o[2] + o[3] * o[3]);
                        }
                }
                ss += __shfl_xor(ss, 16); ss += __shfl_xor(ss, 32);
                if (fq == 0 && row < MR) ssq[(size_t)row * 16 + u.pn * 4 + wc] = ss;
            }
    }
};
struct EpiUp {
    static constexpr bool PERM = true, AFTER_DRAIN = false, GSCALE = false;
    bf16_t* up;
    __device__ __forceinline__ void operator()(const f32x4 (&acc)[2][2][4][2], const Unit& u, int wr, int wc, int fr, int fq) const {
        const int colt = u.pn * 256 + wc * 32 + 8 * fq;
#pragma unroll
        for (int ai = 0; ai < 2; ++ai)
#pragma unroll
            for (int m = 0; m < 4; ++m) {
                const int row = u.pm * 256 + ai * 128 + wr * 64 + m * 16 + fr;
#pragma unroll
                for (int bj = 0; bj < 2; ++bj) {
                    const int col = colt + bj * 128;
                    f32x4 v0 = acc[ai][bj][m][0], v1 = acc[ai][bj][m][1];
#pragma unroll
                    for (int j = 0; j < 4; ++j) { const float a = fmaxf(v0[j], 0.f), b = fmaxf(v1[j], 0.f); v0[j] = a * a; v1[j] = b * b; }
                    u32x4 w; w.x = cvt_pk_bf16(v0[0], v0[1]); w.y = cvt_pk_bf16(v0[2], v0[3]); w.z = cvt_pk_bf16(v1[0], v1[1]); w.w = cvt_pk_bf16(v1[2], v1[3]);
                    *(u32x4*)(up + (size_t)row * DFF + col) = w;
                }
            }
    }
};

struct EpiResidNorm {
    static constexpr bool PERM = false, AFTER_DRAIN = true, GSCALE = false;
    float* out; const float* w; float* xbuf; unsigned* cnt;
    __device__ __forceinline__ void fused(f32x4 (&acc)[2][2][4][2], const Unit& u, int wr, int wc, int fr, int fq, LAS unsigned char* lds, int wid, int lane) const {
        LAS float* P = (LAS float*)lds;
        LAS float* S = (LAS float*)(lds + 4096);
        const int colt = u.pn * 256 + wc * 32 + 4 * fq;
#pragma unroll
        for (int ai = 0; ai < 2; ++ai)
#pragma unroll
            for (int m = 0; m < 4; ++m) {
                const int rl = ai * 128 + wr * 64 + m * 16 + fr;
                const float* brow = out + (size_t)(u.pm * 256 + rl) * 1024;
                float ss = 0.f;
#pragma unroll
                for (int bj = 0; bj < 2; ++bj)
#pragma unroll
                    for (int n = 0; n < 2; ++n) { const f32x4 o = __builtin_nontemporal_load((const f32x4*)(brow + colt + bj * 128 + n * 16)) + acc[ai][bj][m][n]; acc[ai][bj][m][n] = o;
                        ss += (o[0] * o[0] + o[1] * o[1]) + (o[2] * o[2] + o[3] * o[3]); }
                ss += __shfl_xor(ss, 16); ss += __shfl_xor(ss, 32);
                if (fq == 0) P[rl * 4 + wc] = ss;
            }
        __syncthreads();
        const int t = wid * 64 + lane;
        if (t < 256) {
            const float tot = (P[t * 4 + 0] + P[t * 4 + 1]) + (P[t * 4 + 2] + P[t * 4 + 3]);
            __hip_atomic_store(xbuf + (size_t)(u.pm * 256 + t) * 4 + u.pn, tot, __ATOMIC_RELAXED, __HIP_MEMORY_SCOPE_AGENT);
        }
        asm volatile("s_waitcnt vmcnt(0)" ::: "memory");
        __syncthreads();
        if (t == 0) {
            unsigned* c = cnt + 64 * u.pm;
            __hip_atomic_fetch_add(c, 1u, __ATOMIC_RELAXED, __HIP_MEMORY_SCOPE_AGENT);
            unsigned sp = 0;
            while (__hip_atomic_load(c, __ATOMIC_RELAXED, __HIP_MEMORY_SCOPE_AGENT) < 4u) { __builtin_amdgcn_s_sleep(1); if (++sp > (1u << 22)) break; }
            __builtin_amdgcn_fence(__ATOMIC_ACQUIRE, "agent");
            asm volatile("s_waitcnt vmcnt(0)" ::: "memory");
        }
        __syncthreads();
        if (t < 256) {
            const float* sl = xbuf + (size_t)(u.pm * 256 + t) * 4;
            const float a = __hip_atomic_load(sl + 0, __ATOMIC_RELAXED, __HIP_MEMORY_SCOPE_AGENT), b = __hip_atomic_load(sl + 1, __ATOMIC_RELAXED, __HIP_MEMORY_SCOPE_AGENT);
            const float c2 = __hip_atomic_load(sl + 2, __ATOMIC_RELAXED, __HIP_MEMORY_SCOPE_AGENT), d = __hip_atomic_load(sl + 3, __ATOMIC_RELAXED, __HIP_MEMORY_SCOPE_AGENT);
            S[t] = rsqrtf(((a + b) + (c2 + d)) * (1.f / 1024.f) + EPS);
        }
        __syncthreads();
#pragma unroll
        for (int ai = 0; ai < 2; ++ai)
#pragma unroll
            for (int m = 0; m < 4; ++m) {
                const int rl = ai * 128 + wr * 64 + m * 16 + fr;
                const float rs = S[rl];
                float* orow = out + (size_t)(u.pm * 256 + rl) * 1024;
#pragma unroll
                for (int bj = 0; bj < 2; ++bj)
#pragma unroll
                    for (int n = 0; n < 2; ++n) { const int col = colt + bj * 128 + n * 16; __builtin_nontemporal_store(acc[ai][bj][m][n] * rs * *(const f32x4*)(w + col), (f32x4*)(orow + col)); }
            }
    }
};
struct EpiResidNormH2 {
    static constexpr bool PERM = false, AFTER_DRAIN = true, GSCALE = false;
    const float* base; float* out; bf16_t* h2; const float* w; float* xbuf; unsigned* cnt;
    __device__ __forceinline__ void fused(f32x4 (&acc)[2][2][4][2], const Unit& u, int wr, int wc, int fr, int fq, LAS unsigned char* lds, int wid, int lane) const {
        LAS float* P = (LAS float*)lds;
        LAS float* S = (LAS float*)(lds + 4096);
        const int colt = u.pn * 256 + wc * 32 + 4 * fq;
#pragma unroll
        for (int ai = 0; ai < 2; ++ai)
#pragma unroll
            for (int m = 0; m < 4; ++m) {
                const int rl = ai * 128 + wr * 64 + m * 16 + fr;
                const size_t ro = (size_t)(u.pm * 256 + rl) * 1024;
                float ss = 0.f;
#pragma unroll
                for (int bj = 0; bj < 2; ++bj)
#pragma unroll
                    for (int n = 0; n < 2; ++n) { const int col = colt + bj * 128 + n * 16; const f32x4 o = __builtin_nontemporal_load((const f32x4*)(base + ro + col)) + acc[ai][bj][m][n]; acc[ai][bj][m][n] = o;
                        *(f32x4*)(out + ro + col) = o;
                        ss += (o[0] * o[0] + o[1] * o[1]) + (o[2] * o[2] + o[3] * o[3]); }
                ss += __shfl_xor(ss, 16); ss += __shfl_xor(ss, 32);
                if (fq == 0) P[rl * 4 + wc] = ss;
            }
        __syncthreads();
        const int t = wid * 64 + lane;
        if (t < 256) {
            const float tot = (P[t * 4 + 0] + P[t * 4 + 1]) + (P[t * 4 + 2] + P[t * 4 + 3]);
            __hip_atomic_store(xbuf + (size_t)(u.pm * 256 + t) * 4 + u.pn, tot, __ATOMIC_RELAXED, __HIP_MEMORY_SCOPE_AGENT);
        }
        asm volatile("s_waitcnt vmcnt(0)" ::: "memory");
        __syncthreads();
        if (t == 0) {
            unsigned* c = cnt + 64 * u.pm;
            __hip_atomic_fetch_add(c, 1u, __ATOMIC_RELAXED, __HIP_MEMORY_SCOPE_AGENT);
            unsigned sp = 0;
            while (__hip_atomic_load(c, __ATOMIC_RELAXED, __HIP_MEMORY_SCOPE_AGENT) < 4u) { __builtin_amdgcn_s_sleep(1); if (++sp > (1u << 22)) break; }
            __builtin_amdgcn_fence(__ATOMIC_ACQUIRE, "agent");
            asm volatile("s_waitcnt vmcnt(0)" ::: "memory");
        }
        __syncthreads();
        if (t < 256) {
            const float* sl = xbuf + (size_t)(u.pm * 256 + t) * 4;
            const float a = __hip_atomic_load(sl + 0, __ATOMIC_RELAXED, __HIP_MEMORY_SCOPE_AGENT), b = __hip_atomic_load(sl + 1, __ATOMIC_RELAXED, __HIP_MEMORY_SCOPE_AGENT);
            const float c2 = __hip_atomic_load(sl + 2, __ATOMIC_RELAXED, __HIP_MEMORY_SCOPE_AGENT), d = __hip_atomic_load(sl + 3, __ATOMIC_RELAXED, __HIP_MEMORY_SCOPE_AGENT);
            S[t] = rsqrtf(((a + b) + (c2 + d)) * (1.f / 1024.f) + EPS);
        }
        __syncthreads();
#pragma unroll
        for (int ai = 0; ai < 2; ++ai)
#pragma unroll
            for (int m = 0; m < 4; ++m) {
                const int rl = ai * 128 + wr * 64 + m * 16 + fr;
                const float rs = S[rl];
                bf16_t* hrow = h2 + (size_t)(u.pm * 256 + rl) * 1024;
#pragma unroll
                for (int bj = 0; bj < 2; ++bj)
#pragma unroll
                    for (int n = 0; n < 2; ++n) { const int col = colt + bj * 128 + n * 16; const f32x4 ww = *(const f32x4*)(w + col); const f32x4 o = acc[ai][bj][m][n];
                        u32x2 pk; pk.x = cvt_pk_bf16(o[0] * rs * ww[0], o[1] * rs * ww[1]); pk.y = cvt_pk_bf16(o[2] * rs * ww[2], o[3] * rs * ww[3]);
                        *(u32x2*)(hrow + col) = pk; }
            }
    }
};
__device__ __forceinline__ int map_win_col(int j) {
    if (j < 6144) return j;
    if (j < 9216) return j + 32;
    if (j < 11264) return j + 48;
    if (j < 11296) return j - 11264 + 6144;
    if (j < 11304) return j - 11296 + 9248;
    if (j < 11312) return j - 11304 + 9256;
    return -1;
}
struct TWTile { const float* src; bf16_t* dst; const float* ks; int K, Nsrc, k0, n0; float scale; int mode; };
constexpr int TW_WIN = 16 * 90, TW_WUP = 16 * 32, TW_WDN = 64 * 8, TW_WA = 32 * 8, TW_WB = 16 * 8, TW_WO = 16 * 8, TW_WQ = 16, TW_WK = 16;
constexpr int TW_TOTAL = TW_WIN + TW_WUP + TW_WDN + TW_WA + TW_WB + TW_WO + TW_WQ + TW_WK;
__device__ __forceinline__ void tw_get(const Params& p, int g, TWTile& t) {
    unsigned char* ws = p.ws; int nkb; t.scale = 1.f; t.mode = 0; t.ks = nullptr;
    if (g < TW_WIN) { t.src = p.w_in; t.dst = (bf16_t*)(ws + WS_WIN); t.K = 1024; t.Nsrc = 11312; t.mode = 1; nkb = 16; }
    else if ((g -= TW_WIN) < TW_WUP) { t.src = p.w_up; t.dst = (bf16_t*)(ws + WS_WUP); t.K = 1024; t.Nsrc = 4096; nkb = 16; }
    else if ((g -= TW_WUP) < TW_WDN) { t.src = p.w_down; t.dst = (bf16_t*)(ws + WS_WDN); t.K = 4096; t.Nsrc = 1024; nkb = 64; }
    else if ((g -= TW_WDN) < TW_WA) { t.src = p.w_a; t.dst = (bf16_t*)(ws + WS_WA); t.K = 2048; t.Nsrc = 1024; nkb = 32; t.ks = p.m_nw; }
    else if ((g -= TW_WA) < TW_WB) { t.src = p.w_b; t.dst = (bf16_t*)(ws + WS_WB); t.K = 1024; t.Nsrc = 1024; nkb = 16; }
    else if ((g -= TW_WB) < TW_WO) { t.src = p.w_o; t.dst = (bf16_t*)(ws + WS_WO); t.K = 1024; t.Nsrc = 1024; nkb = 16; }
    else if ((g -= TW_WO) < TW_WQ) { const int h = g >> 1; g &= 1; t.src = p.wq + h * 16384; t.dst = (bf16_t*)(ws + WS_WQ) + h * 16384; t.K = 128; t.Nsrc = 128; nkb = 2; }
    else { g -= TW_WQ; const int h = g >> 1; g &= 1; t.src = p.wk + h * 16384; t.dst = (bf16_t*)(ws + WS_WK) + h * 16384; t.K = 128; t.Nsrc = 128; nkb = 2; t.scale = 0.08838834764831845f; }
    t.k0 = (g % nkb) * 64; t.n0 = (g / nkb) * 128;
}
__device__ __forceinline__ void tw_load(const TWTile& t, int tid, f32x4 (&v)[4]) {
#pragma unroll
    for (int i = 0; i < 4; ++i) { const int idx = tid + 512 * i, kk = idx >> 5, n = t.n0 + 4 * (idx & 31);
        const int sc = t.mode == 1 ? map_win_col(n) : n;
        v[i] = sc >= 0 ? __builtin_nontemporal_load((const f32x4*)(t.src + (size_t)(t.k0 + kk) * t.Nsrc + sc)) : (f32x4){0.f, 0.f, 0.f, 0.f}; }
}
__device__ void transpose_all(const Params& p, LAS float* scr) {
    int tid_ = threadIdx.x; asm volatile("" : "+v"(tid_));
    const int tid = tid_;
    int g = blockIdx.x;
    if (g >= TW_TOTAL) return;
    TWTile cur; f32x4 v[4];
    tw_get(p, g, cur); tw_load(cur, tid, v);
    for (;;) {
#pragma unroll
        for (int i = 0; i < 4; ++i) { const int idx = tid + 512 * i, kk = idx >> 5, nl4 = 4 * (idx & 31); LAS float* d = scr + kk * 129 + nl4;
            const float sc_ = cur.ks ? cur.scale * cur.ks[cur.k0 + kk] : cur.scale;
            d[0] = v[i][0] * sc_; d[1] = v[i][1] * sc_; d[2] = v[i][2] * sc_; d[3] = v[i][3] * sc_; }
        const int gn = g + gridDim.x; const bool more = gn < TW_TOTAL;
        TWTile nxt;
        if (more) { tw_get(p, gn, nxt); tw_load(nxt, tid, v); }
        __syncthreads();
        {
            const int nl = tid >> 2, ks = (tid & 3) * 16;
            u32x4 o0, o1;
            const LAS float* s = scr + ks * 129 + nl;
            o0.x = cvt_pk_bf16(s[0 * 129], s[1 * 129]); o0.y = cvt_pk_bf16(s[2 * 129], s[3 * 129]); o0.z = cvt_pk_bf16(s[4 * 129], s[5 * 129]); o0.w = cvt_pk_bf16(s[6 * 129], s[7 * 129]);
            o1.x = cvt_pk_bf16(s[8 * 129], s[9 * 129]); o1.y = cvt_pk_bf16(s[10 * 129], s[11 * 129]); o1.z = cvt_pk_bf16(s[12 * 129], s[13 * 129]); o1.w = cvt_pk_bf16(s[14 * 129], s[15 * 129]);
            bf16_t* d = cur.dst + (size_t)(cur.n0 + nl) * cur.K + cur.k0 + ks;
            *(u32x4*)d = o0; *(u32x4*)(d + 8) = o1;
        }
        __syncthreads();
        if (!more) break;
        cur = nxt; g = gn;
    }
}
__device__ __forceinline__ void rms_row_bf16(const float* xr, float rs_in, bool have_rs, const float* w, bf16_t* orow, int lane) {
    f32x4 v[4]; float s = 0.f;
#pragma unroll
    for (int j = 0; j < 4; ++j) { v[j] = *(const f32x4*)(xr + lane * 4 + 256 * j); s += (v[j][0] * v[j][0] + v[j][1] * v[j][1]) + (v[j][2] * v[j][2] + v[j][3] * v[j][3]); }
    const float rs = have_rs ? rs_in : rsqrtf(wave_sum(s) * (1.f / 1024.f) + EPS);
#pragma unroll
    for (int j = 0; j < 4; ++j) { const f32x4 ww = *(const f32x4*)(w + lane * 4 + 256 * j);
        u32x2 o; o.x = cvt_pk_bf16(v[j][0] * rs * ww[0], v[j][1] * rs * ww[1]); o.y = cvt_pk_bf16(v[j][2] * rs * ww[2], v[j][3] * rs * ww[3]);
        *(u32x2*)(orow + lane * 4 + 256 * j) = o; }
}

__device__ void phase_prep(const Params& p, LAS unsigned char* lds) {
    LAS float* scr = (LAS float*)lds;
    unsigned char* ws = p.ws;
    transpose_all(p, scr);
    int tid_ = threadIdx.x; asm volatile("" : "+v"(tid_));
    const int tid = tid_, lane = tid & 63, wid = __builtin_amdgcn_readfirstlane(tid >> 6);
    bf16_t* xn = (bf16_t*)(ws + WS_XN);
    for (int row = blockIdx.x * 8 + wid; row < MPAD; row += gridDim.x * 8) {
        if (row >= MR) { for (int j = 0; j < 4; ++j) *(u32x2*)(xn + (size_t)row * 1024 + lane * 4 + 256 * j) = (u32x2){0u, 0u}; }
        else { const float* xr = row < MP ? p.x_prompt + (size_t)row * 1024 : p.x_sample + (size_t)(row - MP) * 1024; rms_row_bf16(xr, 0.f, false, p.nmix, xn + (size_t)row * 1024, lane); }
    }
    const size_t gs = (size_t)gridDim.x * 512, g0 = (size_t)blockIdx.x * 512 + tid;
    for (size_t i = g0; i < (size_t)128 * 2 * 4096; i += gs) { const size_t s = i / 8192, r = i % 8192; p.out[OFF_S_MCONV + s * 12288 + r] = p.st_mconv[s * 12288 + 4096 + r]; }
    for (size_t i = g0; i < (size_t)128 * 2 * 1024; i += gs) { const size_t s = i / 2048, r = i % 2048; p.out[OFF_S_LCONV + s * 3072 + r] = p.st_lconv[s * 3072 + 1024 + r]; }
}

constexpr int SQ = 136, SK = 72;
constexpr int L_Q = 0, L_K = 17408, L_KWT = 34816, L_VT = 53248, L_ST = 73984, L_TOK = 113152, L_IO = 115712, L_UC = 133120;
#define MFMA16(a, b, c) __builtin_amdgcn_mfma_f32_16x16x32_bf16(a, b, c, 0, 0, 0)
__device__ __forceinline__ bf16x8 ldfrag(const LAS bf16_t* base, int row, int stride, int k0) { return *(const LAS bf16x8*)(base + row * stride + k0); }

__device__ __forceinline__ void scan_qk(LAS unsigned char* lds, int wid, int l15, int lq) {
    const LAS bf16_t* Q = (const LAS bf16_t*)(lds + L_Q); const LAS bf16_t* K = (const LAS bf16_t*)(lds + L_K);
    LAS bf16_t* WGT = (LAS bf16_t*)(lds + L_UC);
    const LAS float* AL = (const LAS float*)(lds + L_TOK); const LAS float* BE = AL + 64; const LAS float* GA = AL + 128;
    const int sb = wid >> 1;
#pragma unroll
    for (int j = 0; j < 2; ++j) {
        const int rb = (wid & 1) * 2 + j; f32x4 qk = (f32x4){0.f, 0.f, 0.f, 0.f};
        if (rb <= sb) {
#pragma unroll
            for (int ks = 0; ks < 4; ++ks) qk = MFMA16(ldfrag(Q, sb * 16 + l15, SQ, ks * 32 + 8 * lq), ldfrag(K, rb * 16 + l15, SQ, ks * 32 + 8 * lq), qk);
        }
        const int r = rb * 16 + l15; const float be = BE[r], ga = GA[r];
#pragma unroll
        for (int i = 0; i < 4; ++i) { const int s = sb * 16 + lq * 4 + i; const float w = (r <= s) ? qk[i] * __expf(AL[s] + be) * ga : 0.f; WGT[s * SK + r] = f2bf(w); }
    }
    __syncthreads();
}
struct OutFrags { bf16x8 q[4], w[2]; };
__device__ __forceinline__ void scan_out_frags(LAS unsigned char* lds, int sb, int l15, int lq, OutFrags& f) {
    const LAS bf16_t* Q = (const LAS bf16_t*)(lds + L_Q); const LAS bf16_t* WGT = (const LAS bf16_t*)(lds + L_UC);
#pragma unroll
    for (int ks = 0; ks < 4; ++ks) f.q[ks] = ldfrag(Q, sb * 16 + l15, SQ, ks * 32 + 8 * lq);
#pragma unroll
    for (int ks = 0; ks < 2; ++ks) f.w[ks] = ldfrag(WGT, sb * 16 + l15, SK, ks * 32 + 8 * lq);
}
__device__ __forceinline__ f32x4 scan_out_tile(LAS unsigned char* lds, const OutFrags& f, int sb, int vb, int l15, int lq) {
    const LAS bf16_t* VT = (const LAS bf16_t*)(lds + L_VT); const LAS bf16_t* ST = (const LAS bf16_t*)(lds + L_ST);
    const LAS float* SG = (const LAS float*)(lds + L_TOK) + 192;
    bf16x8 bs[4], bv[2];
#pragma unroll
    for (int ks = 0; ks < 4; ++ks) bs[ks] = ldfrag(ST, vb * 16 + l15, SQ, ks * 32 + 8 * lq);
#pragma unroll
    for (int ks = 0; ks < 2; ++ks) bv[ks] = ldfrag(VT, vb * 16 + l15, SK, ks * 32 + 8 * lq);
    f32x4 o = (f32x4){0.f, 0.f, 0.f, 0.f};
#pragma unroll
    for (int ks = 0; ks < 4; ++ks) o = MFMA16(f.q[ks], bs[ks], o);
#pragma unroll
    for (int i = 0; i < 4; ++i) o[i] *= SG[sb * 16 + lq * 4 + i];
#pragma unroll
    for (int ks = 0; ks < 2; ++ks) o = MFMA16(f.w[ks], bv[ks], o);
    return o;
}
struct StateFrags { bf16x8 k[2]; float kap; };
__device__ __forceinline__ void scan_state_frags(LAS unsigned char* lds, int kb, int l15, int lq, StateFrags& f) {
    const LAS bf16_t* KWT = (const LAS bf16_t*)(lds + L_KWT);
#pragma unroll
    for (int ks = 0; ks < 2; ++ks) f.k[ks] = ldfrag(KWT, kb * 16 + l15, SK, ks * 32 + 8 * lq);
    f.kap = ((const LAS float*)(lds + L_TOK))[576];
}
__device__ __forceinline__ void scan_state_tile(LAS unsigned char* lds, const StateFrags& f, f32x4& st, int vb, int kb, int l15, int lq) {
    const LAS bf16_t* VT = (const LAS bf16_t*)(lds + L_VT);
    LAS bf16_t* ST = (LAS bf16_t*)(lds + L_ST);
    bf16x8 av[2];
#pragma unroll
    for (int ks = 0; ks < 2; ++ks) av[ks] = ldfrag(VT, vb * 16 + l15, SK, ks * 32 + 8 * lq);
#pragma unroll
    for (int i = 0; i < 4; ++i) st[i] *= f.kap;
#pragma unroll
    for (int ks = 0; ks < 2; ++ks) st = MFMA16(av[ks], f.k[ks], st);
#pragma unroll
    for (int i = 0; i < 4; ++i) ST[(vb * 16 + lq * 4 + i) * SQ + kb * 16 + l15] = f2bf(st[i]);
}

__device__ void ssd_unit(const Params& p, LAS unsigned char* lds, int b, int h) {
    int tid_ = threadIdx.x; asm volatile("" : "+v"(tid_));
    const int tid = tid_, lane = tid & 63, wid = __builtin_amdgcn_readfirstlane(tid >> 6), l15 = lane & 15, lq = lane >> 4;
    const int g = h >> 2, sb = wid >> 1;
    bf16_t* proj = (bf16_t*)(p.ws + WS_PROJ);
    const float* gates = (const float*)(p.ws + WS_GATES);
    float* gssq = (float*)(p.ws + WS_GSSQ);
    LAS bf16_t* Q = (LAS bf16_t*)(lds + L_Q); LAS bf16_t* K = (LAS bf16_t*)(lds + L_K); LAS bf16_t* KWT = (LAS bf16_t*)(lds + L_KWT);
    LAS bf16_t* VT = (LAS bf16_t*)(lds + L_VT);
    LAS bf16_t* ZS = (LAS bf16_t*)(lds + L_IO);
    LAS float* TOK = (LAS float*)(lds + L_TOK);
    const float A_h = -__expf(p.A_log[h]), dtb = p.dt_bias[h], Dh = p.Dskip[h];
    __syncthreads();
    for (int i = tid; i < 39168 / 4; i += 512) ((LAS unsigned*)(lds + L_ST))[i] = 0u;
    f32x4 st[4];
#pragma unroll
    for (int v = 0; v < 4; ++v) st[v] = (f32x4){0.f, 0.f, 0.f, 0.f};
    int chn[5]; float cw[5][4], cb[5];
    chn[0] = h * 64 + lane; chn[1] = 2048 + g * 128 + lane; chn[2] = chn[1] + 64; chn[3] = 3072 + g * 128 + lane; chn[4] = chn[3] + 64;
#pragma unroll
    for (int q = 0; q < 5; ++q) { cb[q] = p.m_cb[chn[q]];
#pragma unroll
        for (int j = 0; j < 4; ++j) cw[q][j] = p.m_cw[j * 4096 + chn[q]]; }
    const size_t rowb = (size_t)b * TSEQ;
    unsigned rawp[5][6]; float dtr_n; u32x4 zt_n;
    const int zr_ = tid >> 3, zs_ = tid & 7;
    const bf16_t* projc = proj;
#define SSD_ISSUE(cc) do { const int t0n = (cc) * 64; const int tb_ = t0n + 8 * wid - 3; \
        _Pragma("unroll") for (int q = 0; q < 5; ++q) { const bf16_t* bq_ = projc + pidx(rowb, XBC_OFF + chn[q]) + (long)tb_ * 64; \
            _Pragma("unroll") for (int j = 0; j < 12; j += 2) { unsigned lo_ = bq_[j * 64]; unsigned hi_ = (j + 1 < 11) ? (unsigned)bq_[(j + 1) * 64] : 0u; \
                if (tb_ + j < 0) lo_ = 0u; if (tb_ + j + 1 < 0) hi_ = 0u; rawp[q][j >> 1] = lo_ | (hi_ << 16); } } \
        dtr_n = gates[(rowb + t0n + lane) * 64 + h]; \
        zt_n = *(const u32x4*)(projc + pidx(rowb + t0n + zr_, Z_OFF + h * 64 + zs_ * 8)); } while (0)
    SSD_ISSUE(0);
    for (int c = 0; c < 32; ++c) {
        const int t0 = c * 64;
        if (wid == 0) {
            const float dtr = dtr_n;
            const float dt = softplus(dtr + dtb);
            float ac = dt * A_h;
#pragma unroll
            for (int o = 1; o < 64; o <<= 1) { const float t = __shfl_up(ac, o); if (lane >= o) ac += t; }
            const float aL = __shfl(ac, 63);
            TOK[lane] = ac; TOK[64 + lane] = -ac; TOK[128 + lane] = dt; TOK[192 + lane] = __expf(ac); TOK[256 + lane] = __expf(aL - ac) * dt;
            if (lane == 0) TOK[576] = __expf(aL);
        }
        __syncthreads();
        *(LAS u32x4*)(ZS + zr_ * SK + zs_ * 8) = zt_n;
#pragma unroll
        for (int q = 0; q < 5; ++q) {
            float r[11];
#pragma unroll
            for (int j = 0; j < 11; ++j) r[j] = (j & 1) ? bfhi(rawp[q][j >> 1]) : bflo(rawp[q][j >> 1]);
            float y[8];
#pragma unroll
            for (int i = 0; i < 8; ++i) y[i] = silu(cb[q] + r[i] * cw[q][0] + r[i + 1] * cw[q][1] + r[i + 2] * cw[q][2] + r[i + 3] * cw[q][3]);
            if (q == 0) {
                u32x4 w; w.x = cvt_pk_bf16(y[0], y[1]); w.y = cvt_pk_bf16(y[2], y[3]); w.z = cvt_pk_bf16(y[4], y[5]); w.w = cvt_pk_bf16(y[6], y[7]);
                *(LAS u32x4*)(VT + lane * SK + 8 * wid) = w;
            } else if (q <= 2) {
                const int n = (q - 1) * 64 + lane;
                float yw[8];
#pragma unroll
                for (int i = 0; i < 8; ++i) { K[(8 * wid + i) * SQ + n] = f2bf(y[i]); yw[i] = y[i] * TOK[256 + 8 * wid + i]; }
                u32x4 w; w.x = cvt_pk_bf16(yw[0], yw[1]); w.y = cvt_pk_bf16(yw[2], yw[3]); w.z = cvt_pk_bf16(yw[4], yw[5]); w.w = cvt_pk_bf16(yw[6], yw[7]);
                *(LAS u32x4*)(KWT + n * SK + 8 * wid) = w;
            } else {
                const int n = (q - 3) * 64 + lane;
#pragma unroll
                for (int i = 0; i < 8; ++i) Q[(8 * wid + i) * SQ + n] = f2bf(y[i]);
            }
        }
        if (c < 31) SSD_ISSUE(c + 1);
        __syncthreads();
        scan_qk(lds, wid, l15, lq);
        float ss[4] = {0.f, 0.f, 0.f, 0.f};
        {
            f32x4 oo[2];
            OutFrags of; scan_out_frags(lds, sb, l15, lq, of);
#pragma unroll
            for (int j = 0; j < 2; ++j) oo[j] = scan_out_tile(lds, of, sb, (wid & 1) * 2 + j, l15, lq);
#pragma unroll
            for (int j = 0; j < 2; ++j) {
                const int vb = (wid & 1) * 2 + j, pch = vb * 16 + l15;
#pragma unroll
                for (int i = 0; i < 4; ++i) {
                    const int s = sb * 16 + lq * 4 + i;
                    const float xv = bf2f(VT[pch * SK + s]);
                    const float y = (oo[j][i] + Dh * xv) * silu(bf2f(ZS[s * SK + pch]));
                    ZS[s * SK + pch] = f2bf(y);
                    ss[i] += y * y;
                }
            }
        }
#pragma unroll
        for (int i = 0; i < 4; ++i) { float v = ss[i]; v += __shfl_xor(v, 1); v += __shfl_xor(v, 2); v += __shfl_xor(v, 4); v += __shfl_xor(v, 8); if (l15 == 0) TOK[448 + (wid & 1) * 64 + sb * 16 + lq * 4 + i] = v; }
        __syncthreads();
        StateFrags sf; scan_state_frags(lds, wid, l15, lq, sf);
#pragma unroll
        for (int v = 0; v < 4; ++v) scan_state_tile(lds, sf, st[v], v, wid, l15, lq);
        {
            __builtin_nontemporal_store(*(const LAS u32x4*)(ZS + zr_ * SK + zs_ * 8), (u32x4*)((bf16_t*)p.out + (rowb + t0 + zr_) * 2048 + h * 64 + zs_ * 8));
        }
        if (tid < 64) gssq[(rowb + t0 + tid) * 32 + h] = TOK[448 + tid] + TOK[512 + tid];
        __syncthreads();
    }
    float* so = p.out + OFF_P_SSM + ((size_t)(b * 32 + h) * 64) * 128;
#pragma unroll
    for (int v = 0; v < 4; ++v)
#pragma unroll
        for (int i = 0; i < 4; ++i) so[(size_t)(v * 16 + lq * 4 + i) * 128 + wid * 16 + l15] = st[v][i];
}

__device__ void mlstm_unit(const Params& p, LAS unsigned char* lds, int b, int h) {
    int tid_ = threadIdx.x; asm volatile("" : "+v"(tid_));
    const int tid = tid_, lane = tid & 63, wid = __builtin_amdgcn_readfirstlane(tid >> 6), l15 = lane & 15, lq = lane >> 4;
    const int sb = wid >> 1;
    bf16_t* proj = (bf16_t*)(p.ws + WS_PROJ);
    const float* gates = (const float*)(p.ws + WS_GATES);
    const bf16_t* WQT = (const bf16_t*)(p.ws + WS_WQ) + h * 16384;
    const bf16_t* WKT = (const bf16_t*)(p.ws + WS_WK) + h * 16384;
    LAS bf16_t* Q = (LAS bf16_t*)(lds + L_Q); LAS bf16_t* K = (LAS bf16_t*)(lds + L_K); LAS bf16_t* KWT = (LAS bf16_t*)(lds + L_KWT);
    LAS bf16_t* UC = (LAS bf16_t*)(lds + L_UC);
    LAS bf16_t* OS = (LAS bf16_t*)(lds + L_IO);
    LAS bf16_t* VT = (LAS bf16_t*)(lds + L_VT);
    LAS float* TOK = (LAS float*)(lds + L_TOK);
    const float ib = p.i_b[h], fb = p.f_b[h];
    __syncthreads();
    for (int i = tid; i < 39168 / 4; i += 512) ((LAS unsigned*)(lds + L_ST))[i] = 0u;
    for (int i = tid; i < 16 * SK; i += 512) VT[128 * SK + i] = (i < 64) ? (bf16_t)0x3F80u : (bf16_t)0u;
    f32x4 st[9];
#pragma unroll
    for (int v = 0; v < 9; ++v) st[v] = (f32x4){0.f, 0.f, 0.f, 0.f};
    float m0 = 0.f;
    int chn[2]; float cw[2][4], cb[2];
    chn[0] = h * 128 + lane; chn[1] = chn[0] + 64;
#pragma unroll
    for (int q = 0; q < 2; ++q) { cb[q] = p.l_cb[chn[q]];
#pragma unroll
        for (int j = 0; j < 4; ++j) cw[q][j] = p.l_cw[j * 1024 + chn[q]]; }
    const size_t rowb = (size_t)b * TSEQ;
    unsigned rawu[2][6], rawvv[2][4]; float ig_n, fg_n; u32x4 ot_n[2];
    const bf16_t* projc = proj;
#define ML_ISSUE(cc) do { const int t0n = (cc) * 64; const int tb_ = t0n + 8 * wid - 3; \
        _Pragma("unroll") for (int q = 0; q < 2; ++q) { const bf16_t* bq_ = projc + pidx(rowb, U_OFF + chn[q]) + (long)tb_ * 64; \
            _Pragma("unroll") for (int j = 0; j < 12; j += 2) { unsigned lo_ = bq_[j * 64]; unsigned hi_ = (j + 1 < 11) ? (unsigned)bq_[(j + 1) * 64] : 0u; \
                if (tb_ + j < 0) lo_ = 0u; if (tb_ + j + 1 < 0) hi_ = 0u; rawu[q][j >> 1] = lo_ | (hi_ << 16); } \
            const bf16_t* bv_ = projc + pidx(rowb + t0n + 8 * wid, V_OFF + chn[q]); \
            _Pragma("unroll") for (int i = 0; i < 8; i += 2) rawvv[q][i >> 1] = (unsigned)bv_[i * 64] | ((unsigned)bv_[(i + 1) * 64] << 16); } \
        ig_n = gates[(rowb + t0n + lane) * 64 + 32 + h]; fg_n = gates[(rowb + t0n + lane) * 64 + 40 + h]; \
        _Pragma("unroll") for (int k2 = 0; k2 < 2; ++k2) { const int idx = tid + 512 * k2, r_ = idx >> 4, sg_ = idx & 15; \
            ot_n[k2] = *(const u32x4*)(projc + pidx(rowb + t0n + r_, O_OFF + h * 128 + sg_ * 8)); } } while (0)
    ML_ISSUE(0);
    for (int c = 0; c < 32; ++c) {
        const int t0 = c * 64;
        if (wid == 0) {
            const float ig = ig_n + ib;
            const float lf = logsigm(fg_n + fb);
            float bc = lf;
#pragma unroll
            for (int o = 1; o < 64; o <<= 1) { const float t = __shfl_up(bc, o); if (lane >= o) bc += t; }
            const float gg = ig - bc;
            float cm = gg;
#pragma unroll
            for (int o = 1; o < 64; o <<= 1) { const float t = __shfl_up(cm, o); if (lane >= o) cm = fmaxf(cm, t); }
            const float M = fmaxf(m0, cm);
            const float ML = __shfl(M, 63), bL = __shfl(bc, 63);
            TOK[lane] = -M; TOK[64 + lane] = gg; TOK[128 + lane] = 1.f; TOK[192 + lane] = __expf(m0 - M); TOK[256 + lane] = __expf(gg - ML); TOK[320 + lane] = bc + M;
            if (lane == 0) TOK[576] = __expf(m0 - ML);
            m0 = bL + ML;
        }
#pragma unroll
        for (int k2 = 0; k2 < 2; ++k2) {
            const int idx = tid + 512 * k2, r_ = idx >> 4, sg_ = idx & 15;
            if (c > 0) __builtin_nontemporal_store(*(const LAS u32x4*)(OS + r_ * SQ + sg_ * 8), (u32x4*)((bf16_t*)(p.ws + WS_XN) + (rowb + t0 - 64 + r_) * 1024 + h * 128 + sg_ * 8));
            *(LAS u32x4*)(OS + r_ * SQ + sg_ * 8) = ot_n[k2];
        }
#pragma unroll
        for (int q = 0; q < 2; ++q) {
            float r[11];
#pragma unroll
            for (int j = 0; j < 11; ++j) r[j] = (j & 1) ? bfhi(rawu[q][j >> 1]) : bflo(rawu[q][j >> 1]);
#pragma unroll
            for (int i = 0; i < 8; ++i) UC[(8 * wid + i) * SQ + q * 64 + lane] = f2bf(silu(cb[q] + r[i] * cw[q][0] + r[i + 1] * cw[q][1] + r[i + 2] * cw[q][2] + r[i + 3] * cw[q][3]));
            u32x4 w; w.x = rawvv[q][0]; w.y = rawvv[q][1]; w.z = rawvv[q][2]; w.w = rawvv[q][3];
            *(LAS u32x4*)(VT + (q * 64 + lane) * SK + 8 * wid) = w;
        }
        bf16x8 wb[2][8];
#define ML_WLOAD(buf, jj) do { const int e_ = ((wid & 1) * 4 + (jj)) * 16 + l15; \
        _Pragma("unroll") for (int ks = 0; ks < 4; ++ks) { wb[buf][2 * ks] = *(const bf16x8*)(WQT + e_ * 128 + ks * 32 + 8 * lq); wb[buf][2 * ks + 1] = *(const bf16x8*)(WKT + e_ * 128 + ks * 32 + 8 * lq); } } while (0)
        ML_WLOAD(0, 0); ML_WLOAD(1, 1);
        __syncthreads();
        {
            f32x4 qa[4], ka[4];
            bf16x8 af[4];
#pragma unroll
            for (int ks = 0; ks < 4; ++ks) af[ks] = ldfrag(UC, sb * 16 + l15, SQ, ks * 32 + 8 * lq);
#pragma unroll
            for (int j = 0; j < 4; ++j) {
                qa[j] = (f32x4){0.f, 0.f, 0.f, 0.f}; ka[j] = qa[j];
#pragma unroll
                for (int ks = 0; ks < 4; ++ks) { qa[j] = MFMA16(af[ks], wb[j & 1][2 * ks], qa[j]); ka[j] = MFMA16(af[ks], wb[j & 1][2 * ks + 1], ka[j]); }
                asm volatile("" ::: "memory");
                if (j < 2) ML_WLOAD(j & 1, j + 2);
                asm volatile("" ::: "memory");
            }
#pragma unroll
            for (int j = 0; j < 4; ++j) {
                const int e = ((wid & 1) * 4 + j) * 16 + l15, r0 = sb * 16 + lq * 4;
#pragma unroll
                for (int i = 0; i < 4; ++i) { Q[(r0 + i) * SQ + e] = f2bf(qa[j][i]); K[(r0 + i) * SQ + e] = f2bf(ka[j][i]); }
                u32x2 w; w.x = cvt_pk_bf16(ka[j][0] * TOK[256 + r0], ka[j][1] * TOK[256 + r0 + 1]); w.y = cvt_pk_bf16(ka[j][2] * TOK[256 + r0 + 2], ka[j][3] * TOK[256 + r0 + 3]);
                *(LAS u32x2*)(KWT + e * SK + r0) = w;
            }
        }
        if (c < 31) ML_ISSUE(c + 1);
        __syncthreads();
        scan_qk(lds, wid, l15, lq);
        OutFrags of; scan_out_frags(lds, sb, l15, lq, of);
        f32x4 o[5];
#pragma unroll
        for (int j = 0; j < 5; ++j) { const int vb = (wid & 1) * 5 + j; o[j] = (f32x4){0.f, 0.f, 0.f, 0.f}; if (vb < 9) o[j] = scan_out_tile(lds, of, sb, vb, l15, lq); }
        if ((wid & 1) && l15 == 0) {
#pragma unroll
            for (int i = 0; i < 4; ++i) TOK[384 + sb * 16 + lq * 4 + i] = o[3][i];
        }
        {
            float ss[4] = {0.f, 0.f, 0.f, 0.f};
#pragma unroll
            for (int i = 0; i < 4; ++i)
#pragma unroll
                for (int j = 0; j < 5; ++j) { const int vb = (wid & 1) * 5 + j; if (vb < 8) ss[i] += o[j][i] * o[j][i]; }
#pragma unroll
            for (int i = 0; i < 4; ++i) { float v = ss[i]; v += __shfl_xor(v, 1); v += __shfl_xor(v, 2); v += __shfl_xor(v, 4); v += __shfl_xor(v, 8); if (l15 == 0) TOK[448 + (wid & 1) * 64 + sb * 16 + lq * 4 + i] = v; }
        }
        float lnw[5];
#pragma unroll
        for (int j = 0; j < 5; ++j) { const int vb = (wid & 1) * 5 + j; lnw[j] = (vb < 8) ? p.l_nw[h * 128 + vb * 16 + l15] : 0.f; }
        __syncthreads();
#pragma unroll
        for (int i = 0; i < 4; ++i) {
            const int s = sb * 16 + lq * 4 + i;
            const float dn = __builtin_amdgcn_rcpf(fmaxf(fabsf(TOK[384 + s]), __expf(-TOK[320 + s])));
            const float rs = rsqrtf((TOK[448 + s] + TOK[512 + s]) * dn * dn * (1.f / 128.f) + EPS) * dn;
#pragma unroll
            for (int j = 0; j < 5; ++j) { const int vb = (wid & 1) * 5 + j; if (vb < 8) {
                const int e = vb * 16 + l15;
                OS[s * SQ + e] = f2bf(o[j][i] * rs * lnw[j] * sigm(bf2f(OS[s * SQ + e])));
            } }
        }
        StateFrags sf; scan_state_frags(lds, wid, l15, lq, sf);
#pragma unroll
        for (int v = 0; v < 9; ++v) scan_state_tile(lds, sf, st[v], v, wid, l15, lq);
        __syncthreads();
    }
#pragma unroll
    for (int k2 = 0; k2 < 2; ++k2) {
        const int idx = tid + 512 * k2, r_ = idx >> 4, sg_ = idx & 15;
        *(u32x4*)((bf16_t*)(p.ws + WS_XN) + (rowb + 31 * 64 + r_) * 1024 + h * 128 + sg_ * 8) = *(const LAS u32x4*)(OS + r_ * SQ + sg_ * 8);
    }
    float* Co = p.out + OFF_P_C + (size_t)(b * 8 + h) * 16384;
    const int d = wid * 16 + l15;
#pragma unroll
    for (int v = 0; v < 8; ++v) *(f32x4*)(Co + (size_t)d * 128 + v * 16 + lq * 4) = st[v];
    if (lq == 0) p.out[OFF_P_N + (size_t)(b * 8 + h) * 128 + d] = st[8][0];
    if (tid == 0) p.out[OFF_P_M + b * 8 + h] = m0;
}

__device__ void ssd_sample_unit(const Params& p, LAS unsigned char* lds, int s, int g) {
    int tid_ = threadIdx.x; asm volatile("" : "+v"(tid_));
    const int tid = tid_, lane = tid & 63, wid = __builtin_amdgcn_readfirstlane(tid >> 6);
    bf16_t* proj = (bf16_t*)(p.ws + WS_PROJ);
    const float* gates = (const float*)(p.ws + WS_GATES);
    LAS float* F = (LAS float*)lds;
    const size_t row = (size_t)MP + s;
    const size_t sbase = (((size_t)s * 32 + g * 4) * 64 + wid * 32) * 128 + 2 * lane;
    float2 hv[32];
#pragma unroll
    for (int j = 0; j < 32; ++j) { const f32x2v t_ = __builtin_nontemporal_load((const f32x2v*)(p.st_ssm + sbase + (size_t)j * 128)); hv[j].x = t_[0]; hv[j].y = t_[1]; }
    __syncthreads();
    {
        const int ch = tid < 256 ? g * 256 + tid : (tid < 384 ? 2048 + g * 128 + (tid - 256) : 3072 + g * 128 + (tid - 384));
        float y = p.m_cb[ch];
#pragma unroll
        for (int j = 0; j < 3; ++j) y += p.st_mconv[((size_t)s * 3 + j) * 4096 + ch] * p.m_cw[j * 4096 + ch];
        y += p.out[OFF_S_MCONV + ((size_t)s * 3 + 2) * 4096 + ch] * p.m_cw[3 * 4096 + ch];
        F[tid] = silu(y);
        if (tid < 4) { const int h = g * 4 + tid; const float dt = softplus(gates[row * 64 + h] + p.dt_bias[h]); F[776 + tid] = dt; F[780 + tid] = __expf(-dt * __expf(p.A_log[h])); }
    }
    __syncthreads();
    const float Bn0 = F[256 + 2 * lane], Bn1 = F[257 + 2 * lane], Cn0 = F[384 + 2 * lane], Cn1 = F[385 + 2 * lane];
    {
        const int hh = wid >> 1;
        const float dt = F[776 + hh], dA = F[780 + hh];
#pragma unroll
        for (int j = 0; j < 32; ++j) { const int rr = wid * 32 + j;
            const float xv = F[rr];
            float2 hn; hn.x = dA * hv[j].x + dt * xv * Bn0; hn.y = dA * hv[j].y + dt * xv * Bn1;
            { f32x2v t_; t_[0] = hn.x; t_[1] = hn.y; __builtin_nontemporal_store(t_, (f32x2v*)(p.out + OFF_S_SSM + sbase + (size_t)j * 128)); }
            const float y = wave_sum(hn.x * Cn0 + hn.y * Cn1);
            if (lane == 0) F[512 + rr] = y; }
    }
    __syncthreads();
    if (tid < 256) { const int hh = tid >> 6, h = g * 4 + hh, pp = tid & 63;
        const float z = bf2f(proj[pidx(row, Z_OFF + h * 64 + pp)]);
        F[512 + tid] = (F[512 + tid] + p.Dskip[h] * F[hh * 64 + pp]) * silu(z); }
    __syncthreads();
    {
        const float v = tid < 256 ? F[512 + tid] : 0.f;
        const float s2 = wave_sum(v * v);
        if (lane == 0) F[768 + wid] = s2;
    }
    __syncthreads();
    if (tid < 256) {
        const float tot = F[768] + F[769] + F[770] + F[771];
        const float rs = rsqrtf(tot * (1.f / 256.f) + EPS);
        ((bf16_t*)p.out)[row * 2048 + g * 256 + tid] = f2bf(F[512 + tid] * rs);
    }
}

__device__ void mlstm_sample_unit(const Params& p, LAS unsigned char* lds, int s, int h) {
    int tid_ = threadIdx.x; asm volatile("" : "+v"(tid_));
    const int tid = tid_, lane = tid & 63, wid = __builtin_amdgcn_readfirstlane(tid >> 6);
    bf16_t* proj = (bf16_t*)(p.ws + WS_PROJ);
    const float* gates = (const float*)(p.ws + WS_GATES);
    LAS float* F = (LAS float*)lds;
    const size_t row = (size_t)MP + s;
    const int e = tid & 127, qt = tid >> 7;
    const size_t co = ((size_t)s * 8 + h) * 16384 + (size_t)(qt * 32) * 128 + e;
    float cv[32];
#pragma unroll
    for (int dd = 0; dd < 32; ++dd) cv[dd] = __builtin_nontemporal_load(p.st_C + co + (size_t)dd * 128);
    __syncthreads();
    if (tid < 128) {
        const int ch = h * 128 + tid;
        float y = p.l_cb[ch];
#pragma unroll
        for (int j = 0; j < 3; ++j) y += p.st_lconv[((size_t)s * 3 + j) * 1024 + ch] * p.l_cw[j * 1024 + ch];
        y += p.out[OFF_S_LCONV + ((size_t)s * 3 + 2) * 1024 + ch] * p.l_cw[3 * 1024 + ch];
        F[tid] = silu(y);
        F[128 + tid] = bf2f(proj[pidx(row, V_OFF + ch)]);
    }
    if (tid == 0) {
        const float ig = gates[row * 64 + 32 + h] + p.i_b[h];
        const float lf = logsigm(gates[row * 64 + 40 + h] + p.f_b[h]);
        const float m0 = p.st_m[s * 8 + h];
        const float mn = fmaxf(lf + m0, ig);
        F[1544] = __expf(lf + m0 - mn); F[1545] = __expf(ig - mn); F[1546] = mn;
        p.out[OFF_S_M + s * 8 + h] = mn;
    }
    __syncthreads();
    {
        float aq = 0.f, ak = 0.f;
        const float* wqp = p.wq + (size_t)h * 16384 + e; const float* wkp = p.wk + (size_t)h * 16384 + e;
#pragma unroll 16
        for (int dd = 0; dd < 32; ++dd) { const int d = qt * 32 + dd; const float u = F[d]; aq += u * wqp[d * 128]; ak += u * wkp[d * 128]; }
        F[512 + qt * 128 + e] = aq; F[1024 + qt * 128 + e] = ak;
    }
    __syncthreads();
    if (tid < 128) {
        F[256 + tid] = F[512 + tid] + F[640 + tid] + F[768 + tid] + F[896 + tid];
        F[384 + tid] = (F[1024 + tid] + F[1152 + tid] + F[1280 + tid] + F[1408 + tid]) * 0.08838834764831845f;
    }
    __syncthreads();
    const float fg = F[1544], ig = F[1545], mn = F[1546];
    {
        const float ve = F[128 + e];
        float num = 0.f;
#pragma unroll
        for (int dd = 0; dd < 32; ++dd) {
            const int d = qt * 32 + dd;
            const float cn = fg * cv[dd] + ig * F[384 + d] * ve;
            __builtin_nontemporal_store(cn, p.out + OFF_S_C + co + (size_t)dd * 128);
            num += F[256 + d] * cn;
        }
        __syncthreads();
        F[512 + qt * 128 + e] = num;
    }
    float dpart = 0.f;
    if (tid < 128) {
        const size_t no = ((size_t)s * 8 + h) * 128 + tid;
        const float nn = fg * p.st_n[no] + ig * F[384 + tid];
        p.out[OFF_S_N + no] = nn;
        dpart = F[256 + tid] * nn;
    }
    dpart = wave_sum(dpart);
    if (lane == 0) F[1536 + wid] = dpart;
    __syncthreads();
    float hv = 0.f;
    if (tid < 128) {
        const float den = F[1536] + F[1537];
        const float num = F[512 + tid] + F[640 + tid] + F[768 + tid] + F[896 + tid];
        hv = num / fmaxf(fabsf(den), __expf(-mn));
    }
    const float s2 = wave_sum(hv * hv);
    __syncthreads();
    if (lane == 0) F[1536 + wid] = s2;
    __syncthreads();
    if (tid < 128) {
        const float rs = rsqrtf((F[1536] + F[1537]) * (1.f / 128.f) + EPS);
        const size_t ga = pidx(row, O_OFF + h * 128 + tid);
        ((bf16_t*)(p.ws + WS_XN))[row * 1024 + h * 128 + tid] = f2bf(hv * rs * p.l_nw[h * 128 + tid] * sigm(bf2f(proj[ga])));
    }
}

__device__ void phase_scan(const Params& p, LAS unsigned char* lds, int mask) {
    const int nb = gridDim.x, blk = blockIdx.x;
    if (mask & 1) for (int u = blk; u < 64; u += nb) mlstm_unit(p, lds, u >> 3, u & 7);
    if (mask & 2) {
    if (nb > 64) { if (blk >= 64) for (int u = blk - 64; u < 256; u += nb - 64) ssd_unit(p, lds, u >> 5, u & 31); }
    else for (int u = blk; u < 256; u += nb) ssd_unit(p, lds, u >> 5, u & 31);
    }
    if (!(mask & 4)) return;
    int s0 = blk, sstep = nb;
    if (nb > 128) { if (blk < 128) return; s0 = blk - 128; sstep = nb - 128; }
    for (int u = s0; u < 2048; u += sstep) {
        if (u < 1024) ssd_sample_unit(p, lds, u >> 3, u & 7);
        else mlstm_sample_unit(p, lds, (u - 1024) >> 3, (u - 1024) & 7);
    }
}


template <class Epi>
__device__ __forceinline__ void small_gemm(LAS unsigned char* lds, const bf16_t* A, int lda, const bf16_t* Bt, int K, int N, const Epi& e) {
    int tid_ = threadIdx.x; asm volatile("" : "+v"(tid_));
    const int tid = tid_, lane = tid & 63, wid = __builtin_amdgcn_readfirstlane(tid >> 6), l15 = lane & 15, lq = lane >> 4;
    const int half = wid >> 2, kq = wid & 3, kper = K >> 2;
    LAS float* red = (LAS float*)lds;
    const int npairs = 4 * (N >> 4);
    for (int pr = blockIdx.x; pr < npairs; pr += gridDim.x) {
        const int tile = pr * 2 + half, rb = tile & 7, cb = tile >> 3;
        const bf16_t* ap = A + (size_t)(rb * 16 + l15) * lda + kq * kper + 8 * lq;
        const bf16_t* bp = Bt + (size_t)(cb * 16 + l15) * K + kq * kper + 8 * lq;
        f32x4 acc = (f32x4){0.f, 0.f, 0.f, 0.f};
#pragma unroll 8
        for (int k = 0; k < kper; k += 32) acc = MFMA16(*(const bf16x8*)(ap + k), *(const bf16x8*)(bp + k), acc);
        __syncthreads();
#pragma unroll
        for (int i = 0; i < 4; ++i) red[(wid * 4 + i) * 64 + lane] = acc[i];
        __syncthreads();
        if (kq == 0) {
#pragma unroll
            for (int i = 0; i < 4; ++i) {
                const float v = red[((half * 4 + 0) * 4 + i) * 64 + lane] + red[((half * 4 + 1) * 4 + i) * 64 + lane] + red[((half * 4 + 2) * 4 + i) * 64 + lane] + red[((half * 4 + 3) * 4 + i) * 64 + lane];
                e(rb * 16 + lq * 4 + i, cb * 16 + l15, v);
            }
        }
    }
    __syncthreads();
}
__device__ void phase_norm_ya(const Params& p) {
    bf16_t* ya = (bf16_t*)p.out;
    const float* gssq = (const float*)(p.ws + WS_GSSQ);
    int tid_ = threadIdx.x; asm volatile("" : "+v"(tid_));
    const int tid = tid_;
    const int c = (tid & 255) * 8, g = c >> 8;
    const f32x4 n0 = *(const f32x4*)(p.m_nw + c), n1 = *(const f32x4*)(p.m_nw + c + 4);
    const int rstep = gridDim.x * 2;
    for (int row0 = blockIdx.x * 2 + (tid >> 8); row0 < MP; row0 += 4 * rstep) {
        f32x4 q[4]; u32x4 w[4];
#pragma unroll
        for (int k = 0; k < 4; ++k) { const int row = row0 + k * rstep; if (row < MP) { q[k] = *(const f32x4*)(gssq + (size_t)row * 32 + g * 4); w[k] = *(const u32x4*)(ya + (size_t)row * 2048 + c); } }
#pragma unroll
        for (int k = 0; k < 4; ++k) { const int row = row0 + k * rstep; if (row < MP) {
            const float rs = rsqrtf(((q[k][0] + q[k][1]) + (q[k][2] + q[k][3])) * (1.f / 256.f) + EPS);
            u32x4 o;
            o.x = cvt_pk_bf16(bflo(w[k].x) * rs * n0[0], bfhi(w[k].x) * rs * n0[1]); o.y = cvt_pk_bf16(bflo(w[k].y) * rs * n0[2], bfhi(w[k].y) * rs * n0[3]);
            o.z = cvt_pk_bf16(bflo(w[k].z) * rs * n1[0], bfhi(w[k].z) * rs * n1[1]); o.w = cvt_pk_bf16(bflo(w[k].w) * rs * n1[2], bfhi(w[k].w) * rs * n1[3]);
            *(u32x4*)(ya + (size_t)row * 2048 + c) = o; } }
    }
}
__device__ void phase_h2(const Params& p) {
    const float* ssq = (const float*)(p.ws + WS_SSQ);
    bf16_t* h2 = (bf16_t*)(p.ws + WS_XN);
    int tid_ = threadIdx.x; asm volatile("" : "+v"(tid_));
    const int tid = tid_, lane = tid & 63, wid = __builtin_amdgcn_readfirstlane(tid >> 6);
    const int rstep = gridDim.x * 8;
    f32x4 ww[4];
#pragma unroll
    for (int j = 0; j < 4; ++j) ww[j] = *(const f32x4*)(p.nmlp + lane * 4 + 256 * j);
    for (int row0 = MP + blockIdx.x * 8 + wid; row0 < MR; row0 += 2 * rstep) {
        f32x4 v[2][4]; float sp[2];
#pragma unroll
        for (int k = 0; k < 2; ++k) { const int row = row0 + k * rstep; if (row < MR) {
            sp[k] = (lane < 16 && row < MP) ? ssq[(size_t)row * 16 + lane] : 0.f;
#pragma unroll
            for (int j = 0; j < 4; ++j) v[k][j] = *(const f32x4*)(p.out + (size_t)row * 1024 + lane * 4 + 256 * j); } }
#pragma unroll
        for (int k = 0; k < 2; ++k) { const int row = row0 + k * rstep; if (row < MR) {
            float s = sp[k];
            if (row >= MP) { s = 0.f;
#pragma unroll
                for (int j = 0; j < 4; ++j) s += (v[k][j][0] * v[k][j][0] + v[k][j][1] * v[k][j][1]) + (v[k][j][2] * v[k][j][2] + v[k][j][3] * v[k][j][3]); }
            const float rs = rsqrtf(wave_sum(s) * (1.f / 1024.f) + EPS);
#pragma unroll
            for (int j = 0; j < 4; ++j) { u32x2 o; o.x = cvt_pk_bf16(v[k][j][0] * rs * ww[j][0], v[k][j][1] * rs * ww[j][1]); o.y = cvt_pk_bf16(v[k][j][2] * rs * ww[j][2], v[k][j][3] * rs * ww[j][3]);
                *(u32x2*)(h2 + (size_t)row * 1024 + lane * 4 + 256 * j) = o; } } }
    }
}
__device__ void phase_final(const Params& p) {
    const float* ssq = (const float*)(p.ws + WS_SSQ);
    int tid_ = threadIdx.x; asm volatile("" : "+v"(tid_));
    const int tid = tid_, lane = tid & 63, wid = __builtin_amdgcn_readfirstlane(tid >> 6);
    const int rstep = gridDim.x * 8;
    f32x4 ww[4];
#pragma unroll
    for (int j = 0; j < 4; ++j) ww[j] = *(const f32x4*)(p.fnw + lane * 4 + 256 * j);
    for (int row0 = MP + blockIdx.x * 8 + wid; row0 < MR; row0 += 2 * rstep) {
        f32x4 v[2][4]; float sp[2];
#pragma unroll
        for (int k = 0; k < 2; ++k) { const int row = row0 + k * rstep; if (row < MR) {
            sp[k] = (lane < 16 && row < MP) ? ssq[(size_t)row * 16 + lane] : 0.f;
#pragma unroll
            for (int j = 0; j < 4; ++j) v[k][j] = *(const f32x4*)(p.out + (size_t)row * 1024 + lane * 4 + 256 * j); } }
#pragma unroll
        for (int k = 0; k < 2; ++k) { const int row = row0 + k * rstep; if (row < MR) {
            float s = sp[k];
            if (row >= MP) { s = 0.f;
#pragma unroll
                for (int j = 0; j < 4; ++j) s += (v[k][j][0] * v[k][j][0] + v[k][j][1] * v[k][j][1]) + (v[k][j][2] * v[k][j][2] + v[k][j][3] * v[k][j][3]); }
            const float rs = rsqrtf(wave_sum(s) * (1.f / 1024.f) + EPS);
#pragma unroll
            for (int j = 0; j < 4; ++j) *(f32x4*)(p.out + (size_t)row * 1024 + lane * 4 + 256 * j) = v[k][j] * rs * ww[j]; } }
    }
}

#define XB_TMO      128
#define XB_XCNT(j)  (256  + 64 * (j))
#define XB_XSUB(j)  (1280 + 64 * (j))
#define XB_XGEN(j)  (2304 + 64 * (j))
#define XB_TOP      3328
#define XB_TOPGEN   3392
#define XB_SPIN_CAP (1u << 20)
__device__ __forceinline__ unsigned xb_ld(unsigned* p)              { return __hip_atomic_load(p, __ATOMIC_RELAXED, __HIP_MEMORY_SCOPE_AGENT); }
__device__ __forceinline__ unsigned xb_add(unsigned* p, unsigned v) { return __hip_atomic_fetch_add(p, v, __ATOMIC_RELAXED, __HIP_MEMORY_SCOPE_AGENT); }
__device__ __forceinline__ unsigned xb_xcc_id() { return (unsigned)__builtin_amdgcn_s_getreg((3 << 11) | 20) & 0xFu; }
#define XB_SPIN(cond, bar) do { unsigned _sp = 0; while (cond) { __builtin_amdgcn_s_sleep(1); \
    if ((++_sp & 255u) == 0u) { if (xb_ld(&(bar)[XB_TMO])) break; if (_sp > XB_SPIN_CAP) { atomicAdd(&(bar)[XB_TMO], 1u); break; } } } } while (0)
__device__ __forceinline__ void xb_complete(unsigned* bar, unsigned x, unsigned& nloc, unsigned& nx) {
    const unsigned G = gridDim.x;
    unsigned sum, cnt, mine, sp = 0u;
    for (;;) {
        sum = 0u; cnt = 0u; mine = 0u;
#pragma unroll
        for (unsigned j = 0; j < 16; ++j) { const unsigned c = xb_ld(&bar[XB_XCNT(j)]); sum += c; cnt += (c > 0u) ? 1u : 0u; mine = (j == x) ? c : mine; }
        if (sum == G) break;
        __builtin_amdgcn_s_sleep(1);
        if ((++sp & 255u) == 0u) { if (xb_ld(&bar[XB_TMO])) break; if (sp > XB_SPIN_CAP) { atomicAdd(&bar[XB_TMO], 1u); break; } }
    }
    nloc = mine > 0u ? mine : 1u; nx = cnt > 0u ? cnt : 1u;
}
constexpr int LDS_XB = 155648 - 16;
__device__ __forceinline__ void gsync(unsigned* bar, LAS unsigned char* lds) {
    asm volatile("s_waitcnt vmcnt(0) lgkmcnt(0)" ::: "memory");
    __syncthreads();
    if (threadIdx.x == 0) {
        volatile LAS unsigned* st = (volatile LAS unsigned*)(lds + LDS_XB);
        const unsigned x = xb_xcc_id();
        unsigned nloc = st[0], nx = st[1];
        if (nloc == 0u) { xb_complete(bar, x, nloc, nx); st[0] = nloc; st[1] = nx; }
        const unsigned old = xb_add(&bar[XB_XSUB(x)], 1u);
        const unsigned gen = old / nloc;
        if (old + 1u == (gen + 1u) * nloc) {
            __builtin_amdgcn_fence(__ATOMIC_RELEASE, "agent");
            asm volatile("s_waitcnt vmcnt(0)" ::: "memory");
            const unsigned og = xb_add(&bar[XB_TOP], 1u);
            const unsigned tg = og / nx;
            if (og + 1u == (tg + 1u) * nx) xb_add(&bar[XB_TOPGEN], 1u);
            else XB_SPIN(xb_ld(&bar[XB_TOPGEN]) == tg, bar);
            __builtin_amdgcn_fence(__ATOMIC_ACQUIRE, "agent");
            xb_add(&bar[XB_XGEN(x)], 1u);
            asm volatile("s_waitcnt vmcnt(0)" ::: "memory");
        } else {
            XB_SPIN(xb_ld(&bar[XB_XGEN(x)]) == gen, bar);
            __builtin_amdgcn_fence(__ATOMIC_ACQUIRE, "agent");
            asm volatile("s_waitcnt vmcnt(0)" ::: "memory");
        }
    }
    __syncthreads();
}
constexpr int LDS_BYTES = 155648;
typedef const __attribute__((address_space(4))) Params* KargPtr;
__device__ __forceinline__ Params load_params() {
#if defined(__HIP_DEVICE_COMPILE__)
    KargPtr kp = (KargPtr)__builtin_amdgcn_kernarg_segment_ptr();
    asm volatile("" : "+s"(kp));
    return *kp;
#else
    return Params{};
#endif
}
__global__ void __launch_bounds__(512) fwd_megakernel(Params p_arg) {
    extern __shared__ __attribute__((aligned(16))) unsigned char lds_raw[];
    LAS unsigned char* lds = (LAS unsigned char*)lds_raw;
    cg::grid_group grid = cg::this_grid();
    unsigned* gbar;
    { const Params p = load_params(); gbar = (unsigned*)(p.ws + WS_BAR); if (__builtin_expect(p.ws == nullptr, 0)) grid.sync(); }
    if (threadIdx.x == 0) {
        volatile LAS unsigned* st = (volatile LAS unsigned*)(lds + LDS_XB); st[0] = 0u; st[1] = 0u;
        (void)xb_add(&gbar[XB_XCNT(xb_xcc_id())], 1u);
    }
    __syncthreads();
    pg8::StaticOrder S;

    { const Params p = load_params(); phase_prep(p, lds); }
    gsync(gbar, lds);
    {
        const Params p = load_params(); unsigned char* ws = p.ws;
        S.init(MPAD, LDP, gridDim.x, blockIdx.x);
        EpiProj E{(bf16_t*)(ws + WS_PROJ), (float*)(ws + WS_GATES), p.out};
        pg8::gemm_phase(lds, (const bf16_t*)(ws + WS_XN), 1024, (const bf16_t*)(ws + WS_WIN), 1024, S, E);
    }
    gsync(gbar, lds);
    { const Params p = load_params(); phase_scan(p, lds, 7); }
    gsync(gbar, lds);
    {
        const Params p = load_params(); unsigned char* ws = p.ws;
        bf16_t* proj = (bf16_t*)(ws + WS_PROJ);
        S.init(MP, 1024, gridDim.x, blockIdx.x);
        {
            Unit u0; LAS float* rho = (LAS float*)(lds + L_RHO);
            if (S.next(0, u0) && threadIdx.x < 256) {
                const float* gq = (const float*)(ws + WS_GSSQ) + (size_t)(u0.pm * 256 + threadIdx.x) * 32; float rs[8];
#pragma unroll
                for (int g = 0; g < 8; ++g) { const f32x4 q = *(const f32x4*)(gq + g * 4); rs[g] = rsqrtf(((q[0] + q[1]) + (q[2] + q[3])) * (1.f / 256.f) + EPS); }
                rho[threadIdx.x * 8] = rs[7];
#pragma unroll
                for (int g = 1; g < 8; ++g) rho[threadIdx.x * 8 + g] = rs[g - 1] * __builtin_amdgcn_rcpf(rs[g]);
            }
            __syncthreads();
        }
        EpiGateAS EA{proj, lds};
        pg8::gemm_phase(lds, (const bf16_t*)p.out, 2048, (const bf16_t*)(ws + WS_WA), 2048, S, EA);
        __syncthreads();
        EpiGateB EB{proj, (bf16_t*)(ws + WS_MRG)};
        pg8::gemm_phase(lds, (const bf16_t*)(ws + WS_XN), 1024, (const bf16_t*)(ws + WS_WB), 1024, S, EB);
        __syncthreads();
        bf16_t* tmpS = proj + (size_t)(XBC_OFF / 64) * MPAD * 64 + (size_t)MP * 1024;
        bf16_t* mrgS = (bf16_t*)(ws + WS_MRG) + (size_t)MP * 1024;
        small_gemm(lds, (const bf16_t*)p.out + (size_t)MP * 2048, 2048, (const bf16_t*)(ws + WS_WA), 2048, 1024,
                   [=](int r, int c, float v) { tmpS[r * 1024 + c] = f2bf(sigm(bf2f(proj[pidx(MP + r, GA_OFF + c)])) * v); });
        small_gemm(lds, (const bf16_t*)(ws + WS_XN) + (size_t)MP * 1024, 1024, (const bf16_t*)(ws + WS_WB), 1024, 1024,
                   [=](int r, int c, float v) { mrgS[r * 1024 + c] = f2bf(bf2f(tmpS[r * 1024 + c]) + sigm(bf2f(proj[pidx(MP + r, GB_OFF + c)])) * v); });
    }
    gsync(gbar, lds);
    {
        const Params p = load_params(); unsigned char* ws = p.ws;
        S.init(MP, 1024, gridDim.x, blockIdx.x);
        EpiResidNormH2 E{p.x_prompt, p.out, (bf16_t*)(ws + WS_XN), p.nmlp, (float*)(ws + WS_PX), (unsigned*)(ws + WS_PCNT + 16384)};
        pg8::gemm_phase(lds, (const bf16_t*)(ws + WS_MRG), 1024, (const bf16_t*)(ws + WS_WO), 1024, S, E);
        __syncthreads();
        const float* xs = p.x_sample; float* xo = p.out + (size_t)MP * 1024;
        small_gemm(lds, (const bf16_t*)(ws + WS_MRG) + (size_t)MP * 1024, 1024, (const bf16_t*)(ws + WS_WO), 1024, 1024,
                   [=](int r, int c, float v) { xo[r * 1024 + c] = xs[r * 1024 + c] + v; });
    }
    gsync(gbar, lds);
    { const Params p = load_params(); phase_h2(p); }
    gsync(gbar, lds);
    {
        const Params p = load_params(); unsigned char* ws = p.ws;
        S.init(MP, DFF, gridDim.x, blockIdx.x);
        EpiUp E{(bf16_t*)(ws + WS_PROJ)};
        pg8::gemm_phase(lds, (const bf16_t*)(ws + WS_XN), 1024, (const bf16_t*)(ws + WS_WUP), 1024, S, E);
        __syncthreads();
        bf16_t* upS = (bf16_t*)(ws + WS_PROJ) + (size_t)MP * DFF;
        small_gemm(lds, (const bf16_t*)(ws + WS_XN) + (size_t)MP * 1024, 1024, (const bf16_t*)(ws + WS_WUP), 1024, DFF,
                   [=](int r, int c, float v) { const float a = fmaxf(v, 0.f); upS[r * DFF + c] = f2bf(a * a); });
    }
    gsync(gbar, lds);
    {
        const Params p = load_params(); unsigned char* ws = p.ws;
        S.init(MP, 1024, gridDim.x, blockIdx.x);
        EpiResidNorm E{p.out, p.fnw, (float*)(ws + WS_PX), (unsigned*)(ws + WS_PCNT)};
        pg8::gemm_phase(lds, (const bf16_t*)(ws + WS_PROJ), DFF, (const bf16_t*)(ws + WS_WDN), DFF, S, E);
        __syncthreads();
        float* xo = p.out + (size_t)MP * 1024;
        small_gemm(lds, (const bf16_t*)(ws + WS_PROJ) + (size_t)MP * DFF, DFF, (const bf16_t*)(ws + WS_WDN), DFF, 1024,
                   [=](int r, int c, float v) { xo[r * 1024 + c] += v; });
    }
    gsync(gbar, lds);
    { const Params p = load_params(); phase_final(p); }
}

extern "C" void kernel_launch(void* const* d_in, const int* in_sizes, int n_in, void* d_out, int out_size, void* d_ws, size_t ws_size, hipStream_t stream) {
    static int grid_blocks = 0;
    if (grid_blocks == 0) {
        if (ws_size < WS_END) { fprintf(stderr, "kernel_launch: workspace too small: %zu < %zu\n", ws_size, (size_t)WS_END); grid_blocks = -1; return; }
        int dev = 0, cus = 0, per_cu = 0;
        hipGetDevice(&dev);
        hipDeviceGetAttribute(&cus, hipDeviceAttributeMultiprocessorCount, dev);
        if (hipFuncSetAttribute((const void*)fwd_megakernel, hipFuncAttributeMaxDynamicSharedMemorySize, LDS_BYTES) != hipSuccess) { fprintf(stderr, "kernel_launch: hipFuncSetAttribute failed\n"); }
        hipOccupancyMaxActiveBlocksPerMultiprocessor(&per_cu, (const void*)fwd_megakernel, 512, LDS_BYTES);
        (void)hipGetLastError();
        if (per_cu < 1) per_cu = 1;
        grid_blocks = cus;
    }
    if (grid_blocks < 0) return;
    Params p{};
    const float** f = (const float**)&p;
    for (int i = 0; i < 30; ++i) f[i] = (const float*)d_in[i];
    p.out = (float*)d_out; p.ws = (unsigned char*)d_ws;
    (void)hipMemsetAsync((unsigned char*)d_ws + WS_BAR, 0, 49152, stream);
    void* args[] = {&p};
    hipError_t e = hipLaunchCooperativeKernel((const void*)fwd_megakernel, dim3(grid_blocks), dim3(512), args, LDS_BYTES, stream);
    if (e != hipSuccess) fprintf(stderr, "cooperative launch failed: %s (grid %d)\n", hipGetErrorString(e), grid_blocks);
}
```

```cpp
#include <hip/hip_runtime.h>
#include <hip/hip_cooperative_groups.h>
#include <cstdio>
namespace cg = cooperative_groups;

#define LAS __attribute__((address_space(3)))
typedef unsigned short bf16_t;
typedef short bf16x8 __attribute__((ext_vector_type(8)));
typedef float f32x4 __attribute__((ext_vector_type(4)));
typedef unsigned u32x4 __attribute__((ext_vector_type(4)));
typedef unsigned u32x2 __attribute__((ext_vector_type(2)));
typedef float f32x2v __attribute__((ext_vector_type(2)));

constexpr int DM = 1024, TSEQ = 2048, NBATCH = 8, NSAMP = 128;
constexpr int MP = NBATCH * TSEQ;
constexpr int MR = MP + NSAMP;
constexpr int MPAD = 16640;
constexpr int LDP = 11520;
constexpr int Z_OFF = 0, XBC_OFF = 2048, U_OFF = 6144, V_OFF = 7168, O_OFF = 8192, GA_OFF = 9216, GB_OFF = 10240, G_OFF = 11264;
constexpr int DFF = 4096;
constexpr float EPS = 1e-6f;
constexpr size_t OFF_Y = 0;
constexpr size_t OFF_P_MCONV = (size_t)MR * 1024;
constexpr size_t OFF_P_SSM = OFF_P_MCONV + 8 * 3 * 4096;
constexpr size_t OFF_P_LCONV = OFF_P_SSM + (size_t)8 * 32 * 64 * 128;
constexpr size_t OFF_P_C = OFF_P_LCONV + 8 * 3 * 1024;
constexpr size_t OFF_P_N = OFF_P_C + (size_t)8 * 8 * 128 * 128;
constexpr size_t OFF_P_M = OFF_P_N + 8 * 8 * 128;
constexpr size_t OFF_S_MCONV = OFF_P_M + 64;
constexpr size_t OFF_S_SSM = OFF_S_MCONV + (size_t)128 * 3 * 4096;
constexpr size_t OFF_S_LCONV = OFF_S_SSM + (size_t)128 * 32 * 64 * 128;
constexpr size_t OFF_S_C = OFF_S_LCONV + (size_t)128 * 3 * 1024;
constexpr size_t OFF_S_N = OFF_S_C + (size_t)128 * 8 * 128 * 128;
constexpr size_t OFF_S_M = OFF_S_N + (size_t)128 * 8 * 128;
constexpr size_t WS_WIN = 0;
constexpr size_t WS_WA = WS_WIN + (size_t)LDP * 1024 * 2;
constexpr size_t WS_WB = WS_WA + (size_t)1024 * 2048 * 2;
constexpr size_t WS_WO = WS_WB + (size_t)1024 * 1024 * 2;
constexpr size_t WS_WUP = WS_WO + (size_t)1024 * 1024 * 2;
constexpr size_t WS_WDN = WS_WUP + (size_t)4096 * 1024 * 2;
constexpr size_t WS_WQ = WS_WDN + (size_t)4096 * 1024 * 2;
constexpr size_t WS_WK = WS_WQ + (size_t)8 * 128 * 128 * 2;
constexpr size_t WS_XN = WS_WK + (size_t)8 * 128 * 128 * 2;
constexpr size_t WS_PROJ = WS_XN + (size_t)MPAD * 1024 * 2;
constexpr size_t WS_GATES = WS_PROJ + (size_t)MPAD * LDP * 2;
constexpr size_t WS_GSSQ = WS_GATES + (size_t)MPAD * 64 * 4;
constexpr size_t WS_SSQ = WS_GSSQ + (size_t)MP * 32 * 4;
constexpr size_t WS_MRG = WS_SSQ + (size_t)MPAD * 16 * 4;
constexpr size_t WS_BAR = WS_MRG + (size_t)MPAD * 1024 * 2;
constexpr size_t WS_PCNT = WS_BAR + 16384;
constexpr size_t WS_PX = WS_PCNT + 32768;
constexpr size_t WS_END = WS_PX + (size_t)MP * 4 * 4;

__device__ __forceinline__ size_t pidx(size_t row, int col) { return ((size_t)(col >> 6) * MPAD + row) * 64 + (col & 63); }
struct Params {
    const float *x_prompt, *x_sample, *st_mconv, *st_ssm, *st_lconv, *st_C, *st_n, *st_m;
    const float *w_in, *m_cw, *m_cb, *dt_bias, *A_log, *Dskip, *m_nw, *w_a, *l_cw, *l_cb, *wq, *wk, *i_b, *f_b, *l_nw, *w_b, *w_o, *nmix, *nmlp, *w_up, *w_down, *fnw;
    float* out;
    unsigned char* ws;
};

typedef __bf16 bf16v2_t __attribute__((ext_vector_type(2)));
__device__ __forceinline__ unsigned cvt_pk_bf16(float lo, float hi) { bf16v2_t v; v[0] = (__bf16)lo; v[1] = (__bf16)hi; return __builtin_bit_cast(unsigned, v); }
__device__ __forceinline__ bf16_t f2bf(float f) { return __builtin_bit_cast(bf16_t, (__bf16)f); }
__device__ __forceinline__ float bf2f(bf16_t b) { return __uint_as_float(((unsigned)b) << 16); }
__device__ __forceinline__ float bflo(unsigned w) { return __uint_as_float(w << 16); }
__device__ __forceinline__ float bfhi(unsigned w) { return __uint_as_float(w & 0xffff0000u); }
__device__ __forceinline__ float sigm(float x) { return __builtin_amdgcn_rcpf(1.f + __expf(-x)); }
__device__ __forceinline__ float silu(float x) { return x * __builtin_amdgcn_rcpf(1.f + __expf(-x)); }
__device__ __forceinline__ float softplus(float x) { return fmaxf(x, 0.f) + __logf(1.f + __expf(-fabsf(x))); }
__device__ __forceinline__ float logsigm(float x) { return fminf(x, 0.f) - __logf(1.f + __expf(-fabsf(x))); }
__device__ __forceinline__ float wave_sum(float v) {
#pragma unroll
    for (int o = 1; o < 64; o <<= 1) v += __shfl_xor(v, o);
    return v;
}

namespace pg8 {
constexpr int BM = 256, BK = 64, HALF = 128, HTB = HALF * BK * 2, STAGE_BYTES = 8 * HTB, NXCD = 8, WGM = 8;
__host__ __device__ __forceinline__ int lds_byte(int r, int c) { const int st = (r >> 4) * 2 + (c >> 5), rr = r & 15, cc = c & 31, ob = rr * 64 + cc * 2; return st * 1024 + (ob ^ (((ob >> 9) & 1) << 5)); }
__host__ __device__ __forceinline__ void stage_rc(int b, int& R, int& C) { const int st = b / 1024, sb = b % 1024, swz = sb ^ (((sb >> 9) & 1) << 5); R = (st >> 1) * 16 + swz / 64; C = (st & 1) * 32 + (swz % 64) / 2; }
__host__ __device__ __forceinline__ int perm32(int rho) { const int n = rho >> 4, i = rho & 15; return 8 * (i >> 2) + 4 * n + (i & 3); }
struct Unit { int pm, pn; };
struct StaticOrder {
    int nM, nN, nwg, G, c;
    __device__ void init(int M, int N, int G_, int c_) { nM = M / BM; nN = N / BM; nwg = nM * nN; G = G_; c = c_; }
    __device__ bool next(int i, Unit& u) const {
        const long L = (long)i * G + c; if (L >= nwg) return false;
        int wgid = (int)L; { const int q = nwg / NXCD, r = nwg % NXCD, xcd = wgid % NXCD, off = wgid / NXCD; wgid = (xcd < r ? xcd * (q + 1) : r * (q + 1) + (xcd - r) * q) + off; }
        const int nig = WGM * nN, gid = wgid / nig, fm = gid * WGM, gsz = (nM - fm) < WGM ? (nM - fm) : WGM;
        u.pm = fm + ((wgid % nig) % gsz); u.pn = (wgid % nig) / gsz; return true;
    }
};

template <class Epi>
__device__ __forceinline__ void gemm_phase(LAS unsigned char* lds, const bf16_t* A, int lda, const bf16_t* Bt, int K, const StaticOrder& S, const Epi& E) {
    int tid_ = threadIdx.x; asm volatile("" : "+v"(tid_));
    const int tid = tid_, wid = __builtin_amdgcn_readfirstlane(tid >> 6), lane = tid & 63, wr = wid >> 2, wc = wid & 3, fr = lane & 15, fq = lane >> 4;
    const int nt = K / BK;
    unsigned voffA[2], voffB[2];
#pragma unroll
    for (int i = 0; i < 2; ++i) { int R, C; stage_rc(tid * 16 + i * 8192, R, C); const int Rb = Epi::PERM ? ((R & ~31) + perm32(R & 31)) : R;
        voffA[i] = (unsigned)(R * lda + C) * 2u; voffB[i] = (unsigned)(Rb * K + C) * 2u; }
    const size_t kstep = (size_t)(BK * 2);
    const size_t hstepA = (size_t)HALF * lda * 2, hstepB = (size_t)HALF * K * 2;
    const size_t tstepA = 2 * hstepA, tstepB = 2 * hstepB;
    const unsigned ldsw = (unsigned)wid * 1024u;
    const int aoff = lds_byte(wr * 64 + fr, fq * 8), boff = lds_byte(wc * 32 + fr, fq * 8);
#define PG8_SA(b, h) (((b) * 2 + (h)) * HTB)
#define PG8_SB(b, h) ((4 + (b) * 2 + (h)) * HTB)
#define PG8_STAGE(bufoff, gbase, voff) do { _Pragma("unroll") for (int _i = 0; _i < 2; ++_i) \
        __builtin_amdgcn_global_load_lds((const unsigned*)((const char*)(gbase) + (voff)[_i]), (LAS unsigned*)(lds + (bufoff) + ldsw + _i * 8192), 16, 0, 0); } while (0)
#define PG8_LDA(dst, b, h) do { _Pragma("unroll") for (int m = 0; m < 4; ++m) _Pragma("unroll") for (int k = 0; k < 2; ++k) dst[m][k] = *(const LAS bf16x8*)(lds + PG8_SA(b, h) + aoff + m * 2048 + k * 1024); } while (0)
#define PG8_LDB(dst, b, h) do { _Pragma("unroll") for (int n = 0; n < 2; ++n) _Pragma("unroll") for (int k = 0; k < 2; ++k) dst[n][k] = *(const LAS bf16x8*)(lds + PG8_SB(b, h) + boff + n * 2048 + k * 1024); } while (0)
#define PG8_MMA(ai, bj, At, Bt_) do { __builtin_amdgcn_s_setprio(1); _Pragma("unroll") for (int m = 0; m < 4; ++m) _Pragma("unroll") for (int n = 0; n < 2; ++n) _Pragma("unroll") for (int k = 0; k < 2; ++k) \
        acc[ai][bj][m][n] = __builtin_amdgcn_mfma_f32_16x16x32_bf16(Bt_[n][k], At[m][k], acc[ai][bj][m][n], 0, 0, 0); __builtin_amdgcn_s_setprio(0); } while (0)
#define PG8_WAIT_V(n) asm volatile("s_waitcnt vmcnt(" #n ")" ::: "memory")
#define PG8_WAIT_L(n) asm volatile("s_waitcnt lgkmcnt(" #n ")" ::: "memory")
#define PG8_BAR __builtin_amdgcn_s_barrier()
#define PG8_SCHED __builtin_amdgcn_sched_barrier(0)
    Unit cur, nxt; int ui = 0;
    if (!S.next(0, cur)) return;
    f32x4 acc[2][2][4][2];
#pragma unroll
    for (int a = 0; a < 2; ++a)
#pragma unroll
        for (int b = 0; b < 2; ++b)
#pragma unroll
            for (int m = 0; m < 4; ++m)
#pragma unroll
                for (int n = 0; n < 2; ++n) acc[a][b][m][n] = (f32x4){0.f, 0.f, 0.f, 0.f};
    bf16x8 At[4][2], B0[2][2], B1[2][2];
    const char* cA = (const char*)A + (size_t)cur.pm * tstepA; const char* cB = (const char*)Bt + (size_t)cur.pn * tstepB;
    PG8_STAGE(PG8_SB(0, 0), cB, voffB); PG8_STAGE(PG8_SA(0, 0), cA, voffA); PG8_STAGE(PG8_SB(0, 1), cB + hstepB, voffB); PG8_STAGE(PG8_SA(0, 1), cA + hstepA, voffA);
    if (wr == 1) PG8_BAR;
    PG8_WAIT_V(4); PG8_BAR;
    PG8_STAGE(PG8_SB(1, 0), cB + kstep, voffB); PG8_STAGE(PG8_SA(1, 0), cA + kstep, voffA); PG8_STAGE(PG8_SB(1, 1), cB + hstepB + kstep, voffB);
    PG8_WAIT_V(6); PG8_BAR;
    for (;;) {
        const bool has_next = Epi::GSCALE ? false : S.next(ui + 1, nxt);
        const char* nA = has_next ? (const char*)A + (size_t)nxt.pm * tstepA : cA; const char* nB = has_next ? (const char*)Bt + (size_t)nxt.pn * tstepB : cB;
        for (int t = 0; t < nt; t += 2) {
            if constexpr (Epi::GSCALE) { if (t > 0 && (t & 3) == 0) { E.gscale(acc, lds, t >> 2, wr, fr); PG8_SCHED; } }
            const bool last = (t == nt - 2);
            const char* a1 = cA + (size_t)(t + 1) * kstep;
            const char* a2 = last ? nA : cA + (size_t)(t + 2) * kstep; const char* b2 = last ? nB : cB + (size_t)(t + 2) * kstep;
            const char* a3 = a2 + kstep; const char* b3 = b2 + kstep;
            PG8_LDB(B0, 0, 0); PG8_SCHED; PG8_LDA(At, 0, 0); PG8_STAGE(PG8_SA(1, 1), a1 + hstepA, voffA);
            PG8_WAIT_L(8); PG8_BAR; PG8_WAIT_L(0); PG8_MMA(0, 0, At, B0); PG8_BAR; PG8_SCHED;
            PG8_LDB(B1, 0, 1); PG8_STAGE(PG8_SB(0, 0), b2, voffB);
            PG8_BAR; PG8_WAIT_L(0); PG8_MMA(0, 1, At, B1); PG8_BAR;
            PG8_LDA(At, 0, 1); PG8_STAGE(PG8_SA(0, 0), a2, voffA);
            PG8_BAR; PG8_WAIT_L(0); PG8_MMA(1, 0, At, B0); PG8_BAR; PG8_SCHED;
            PG8_STAGE(PG8_SB(0, 1), b2 + hstepB, voffB);
            PG8_WAIT_V(6); PG8_BAR; PG8_MMA(1, 1, At, B1); PG8_BAR;
            PG8_LDB(B0, 1, 0); PG8_SCHED; PG8_LDA(At, 1, 0); PG8_STAGE(PG8_SA(0, 1), a2 + hstepA, voffA);
            PG8_WAIT_L(8); PG8_BAR; PG8_WAIT_L(0); PG8_MMA(0, 0, At, B0); PG8_BAR; PG8_SCHED;
            PG8_LDB(B1, 1, 1); PG8_STAGE(PG8_SB(1, 0), b3, voffB);
            PG8_BAR; PG8_WAIT_L(0); PG8_MMA(0, 1, At, B1); PG8_BAR;
            PG8_LDA(At, 1, 1); PG8_STAGE(PG8_SA(1, 0), a3, voffA);
            PG8_BAR; PG8_WAIT_L(0); PG8_MMA(1, 0, At, B0); PG8_BAR; PG8_SCHED;
            PG8_STAGE(PG8_SB(1, 1), b3 + hstepB, voffB);
            PG8_WAIT_V(6); PG8_BAR; PG8_MMA(1, 1, At, B1); PG8_BAR;
        }
        if constexpr (!Epi::AFTER_DRAIN) E(acc, cur, wr, wc, fr, fq);
        if (!has_next) break;
#pragma unroll
        for (int a = 0; a < 2; ++a)
#pragma unroll
            for (int b = 0; b < 2; ++b)
#pragma unroll
                for (int m = 0; m < 4; ++m)
#pragma unroll
                    for (int n = 0; n < 2; ++n) acc[a][b][m][n] = (f32x4){0.f, 0.f, 0.f, 0.f};
        cur = nxt; cA = nA; cB = nB; ++ui;
    }
    PG8_WAIT_V(0);
    if (wr == 0) PG8_BAR;
    PG8_BAR;
    if constexpr (Epi::AFTER_DRAIN) E.fused(acc, cur, wr, wc, fr, fq, lds, wid, lane);
#undef PG8_SA
#undef PG8_SB
#undef PG8_STAGE
#undef PG8_LDA
#undef PG8_LDB
#undef PG8_MMA
#undef PG8_WAIT_V
#undef PG8_WAIT_L
#undef PG8_BAR
#undef PG8_SCHED
}
}
using pg8::Unit;

struct EpiProj {
    static constexpr bool PERM = true, AFTER_DRAIN = false, GSCALE = false;
    bf16_t* proj; float* gates; float* out;
    __device__ __forceinline__ void operator()(const f32x4 (&acc)[2][2][4][2], const Unit& u, int wr, int wc, int fr, int fq) const {
        const int colt = u.pn * 256 + wc * 32 + 8 * fq;
#pragma unroll
        for (int ai = 0; ai < 2; ++ai)
#pragma unroll
            for (int m = 0; m < 4; ++m) {
                const int row = u.pm * 256 + ai * 128 + wr * 64 + m * 16 + fr;
                int srow = -1; bool samp = false;
                if (row < MP) { const int t = row & (TSEQ - 1); if (t >= TSEQ - 3) srow = (row >> 11) * 3 + (t - (TSEQ - 3)); }
                else if (row < MR) { srow = (row - MP) * 3 + 2; samp = true; }
#pragma unroll
                for (int bj = 0; bj < 2; ++bj) {
                    const int col = colt + bj * 128;
                    const f32x4 v0 = acc[ai][bj][m][0], v1 = acc[ai][bj][m][1];
                    u32x4 w; w.x = cvt_pk_bf16(v0[0], v0[1]); w.y = cvt_pk_bf16(v0[2], v0[3]); w.z = cvt_pk_bf16(v1[0], v1[1]); w.w = cvt_pk_bf16(v1[2], v1[3]);
                    __builtin_nontemporal_store(w, (u32x4*)(proj + pidx(row, col)));
                    if (u.pn == 44 && bj == 0 && wc < 2) { float* g = gates + (size_t)row * 64 + wc * 32 + 8 * fq; *(f32x4*)g = v0; *(f32x4*)(g + 4) = v1; }
                    if (srow >= 0 && col >= XBC_OFF && col < V_OFF) {
                        float* d;
                        if (col < U_OFF) d = out + (samp ? OFF_S_MCONV : OFF_P_MCONV) + (size_t)srow * 4096 + (col - XBC_OFF);
                        else d = out + (samp ? OFF_S_LCONV : OFF_P_LCONV) + (size_t)srow * 1024 + (col - U_OFF);
                        *(f32x4*)d = v0; *(f32x4*)(d + 4) = v1;
                    }
                }
            }
    }
};
struct EpiGateA {
    static constexpr bool PERM = true, AFTER_DRAIN = false, GSCALE = false;
    bf16_t* proj;
    __device__ __forceinline__ void operator()(const f32x4 (&acc)[2][2][4][2], const Unit& u, int wr, int wc, int fr, int fq) const {
        const int colt = u.pn * 256 + wc * 32 + 8 * fq;
#pragma unroll
        for (int ai = 0; ai < 2; ++ai)
#pragma unroll
            for (int m = 0; m < 4; ++m) {
                const int row = u.pm * 256 + ai * 128 + wr * 64 + m * 16 + fr;
                if (row < MR) {
#pragma unroll
                    for (int bj = 0; bj < 2; ++bj) {
                        const int col = colt + bj * 128;
                        const u32x4 g = *(const u32x4*)(proj + pidx(row, GA_OFF + col));
                        const f32x4 a0 = acc[ai][bj][m][0], a1 = acc[ai][bj][m][1];
                        f32x4 o0, o1;
                        o0[0] = sigm(bflo(g.x)) * a0[0]; o0[1] = sigm(bfhi(g.x)) * a0[1]; o0[2] = sigm(bflo(g.y)) * a0[2]; o0[3] = sigm(bfhi(g.y)) * a0[3];
                        o1[0] = sigm(bflo(g.z)) * a1[0]; o1[1] = sigm(bfhi(g.z)) * a1[1]; o1[2] = sigm(bflo(g.w)) * a1[2]; o1[3] = sigm(bfhi(g.w)) * a1[3];
                        float* d = (float*)(proj + (size_t)(XBC_OFF / 64) * MPAD * 64) + (size_t)row * 1024 + col;
                        *(f32x4*)d = o0; *(f32x4*)(d + 4) = o1;
                    }
                }
            }
    }
};
constexpr int L_RHO = 131072;
struct EpiGateAS {
    static constexpr bool PERM = true, AFTER_DRAIN = false, GSCALE = true;
    bf16_t* proj; LAS unsigned char* lds;
    __device__ __forceinline__ void gscale(f32x4 (&acc)[2][2][4][2], LAS unsigned char* lds, int g, int wr, int fr) const {
        const LAS float* rho = (const LAS float*)(lds + L_RHO);
#pragma unroll
        for (int ai = 0; ai < 2; ++ai)
#pragma unroll
            for (int m = 0; m < 4; ++m) { const float r = rho[(ai * 128 + wr * 64 + m * 16 + fr) * 8 + g];
#pragma unroll
                for (int bj = 0; bj < 2; ++bj)
#pragma unroll
                    for (int n = 0; n < 2; ++n) acc[ai][bj][m][n] *= r;
                __builtin_amdgcn_sched_barrier(0); }
    }
    __device__ __forceinline__ void operator()(const f32x4 (&acc)[2][2][4][2], const Unit& u, int wr, int wc, int fr, int fq) const {
        const int colt = u.pn * 256 + wc * 32 + 8 * fq;
#pragma unroll
        for (int ai = 0; ai < 2; ++ai)
#pragma unroll
            for (int m = 0; m < 4; ++m) {
                const int row = u.pm * 256 + ai * 128 + wr * 64 + m * 16 + fr;
                const float rsl = ((const LAS float*)(lds + L_RHO))[(ai * 128 + wr * 64 + m * 16 + fr) * 8];
                if (row < MR) {
#pragma unroll
                    for (int bj = 0; bj < 2; ++bj) {
                        const int col = colt + bj * 128;
                        const u32x4 g = *(const u32x4*)(proj + pidx(row, GA_OFF + col));
                        const f32x4 a0 = acc[ai][bj][m][0] * rsl, a1 = acc[ai][bj][m][1] * rsl;
                        f32x4 o0, o1;
                        o0[0] = sigm(bflo(g.x)) * a0[0]; o0[1] = sigm(bfhi(g.x)) * a0[1]; o0[2] = sigm(bflo(g.y)) * a0[2]; o0[3] = sigm(bfhi(g.y)) * a0[3];
                        o1[0] = sigm(bflo(g.z)) * a1[0]; o1[1] = sigm(bfhi(g.z)) * a1[1]; o1[2] = sigm(bflo(g.w)) * a1[2]; o1[3] = sigm(bfhi(g.w)) * a1[3];
                        u32x4 tw; tw.x = cvt_pk_bf16(o0[0], o0[1]); tw.y = cvt_pk_bf16(o0[2], o0[3]); tw.z = cvt_pk_bf16(o1[0], o1[1]); tw.w = cvt_pk_bf16(o1[2], o1[3]);
                        *(u32x4*)(proj + (size_t)(XBC_OFF / 64) * MPAD * 64 + (size_t)row * 1024 + col) = tw;
                    }
                }
            }
    }
};
struct EpiGateB {
    static constexpr bool PERM = true, AFTER_DRAIN = false, GSCALE = false;
    const bf16_t* proj; bf16_t* merged;
    __device__ __forceinline__ void operator()(const f32x4 (&acc)[2][2][4][2], const Unit& u, int wr, int wc, int fr, int fq) const {
        const int colt = u.pn * 256 + wc * 32 + 8 * fq;
#pragma unroll
        for (int ai = 0; ai < 2; ++ai)
#pragma unroll
            for (int m = 0; m < 4; ++m) {
                const int row = u.pm * 256 + ai * 128 + wr * 64 + m * 16 + fr;
#pragma unroll
                for (int bj = 0; bj < 2; ++bj) {
                    const int col = colt + bj * 128;
                    f32x4 o0 = (f32x4){0.f, 0.f, 0.f, 0.f}, o1 = o0;
                    if (row < MR) {
                        const u32x4 g = *(const u32x4*)(proj + pidx(row, GB_OFF + col));
                        const u32x4 tw = *(const u32x4*)(proj + (size_t)(XBC_OFF / 64) * MPAD * 64 + (size_t)row * 1024 + col);
                        const f32x4 t0 = (f32x4){bflo(tw.x), bfhi(tw.x), bflo(tw.y), bfhi(tw.y)}, t1 = (f32x4){bflo(tw.z), bfhi(tw.z), bflo(tw.w), bfhi(tw.w)};
                        const f32x4 a0 = acc[ai][bj][m][0], a1 = acc[ai][bj][m][1];
                        o0[0] = t0[0] + sigm(bflo(g.x)) * a0[0]; o0[1] = t0[1] + sigm(bfhi(g.x)) * a0[1]; o0[2] = t0[2] + sigm(bflo(g.y)) * a0[2]; o0[3] = t0[3] + sigm(bfhi(g.y)) * a0[3];
                        o1[0] = t1[0] + sigm(bflo(g.z)) * a1[0]; o1[1] = t1[1] + sigm(bfhi(g.z)) * a1[1]; o1[2] = t1[2] + sigm(bflo(g.w)) * a1[2]; o1[3] = t1[3] + sigm(bfhi(g.w)) * a1[3];
                    }
                    u32x4 w; w.x = cvt_pk_bf16(o0[0], o0[1]); w.y = cvt_pk_bf16(o0[2], o0[3]); w.z = cvt_pk_bf16(o1[0], o1[1]); w.w = cvt_pk_bf16(o1[2], o1[3]);
                    *(u32x4*)(merged + (size_t)row * 1024 + col) = w;
                }
            }
    }
};
struct EpiResid {
    static constexpr bool PERM = false, AFTER_DRAIN = false, GSCALE = false;
    const float* xp; const float* xs;
    float* out; float* ssq;
    __device__ __forceinline__ void operator()(const f32x4 (&acc)[2][2][4][2], const Unit& u, int wr, int wc, int fr, int fq) const {
        const int colt = u.pn * 256 + wc * 32 + 4 * fq;
#pragma unroll
        for (int ai = 0; ai < 2; ++ai)
#pragma unroll
            for (int m = 0; m < 4; ++m) {
                const int row = u.pm * 256 + ai * 128 + wr * 64 + m * 16 + fr;
                float ss = 0.f;
                if (row < MR) {
                    const float* base = (row < MP) ? xp + (size_t)row * 1024 : xs + (size_t)(row - MP) * 1024;
                    float* orow = out + (size_t)row * 1024;
#pragma unroll
                    for (int bj = 0; bj < 2; ++bj)
#pragma unroll
                        for (int n = 0; n < 2; ++n) {
                            const int col = colt + bj * 128 + n * 16;
                            const f32x4 o = *(const f32x4*)(base + col) + acc[ai][bj][m][n];
                            *(f32x4*)(orow + col) = o;
                            ss += (o[0] * o[0] + o[1] * o[1]) + (o[2] * o[2] + o[3] * o[3]);
                        }
                }
                ss += __shfl_xor(ss, 16); ss += __shfl_xor(ss, 32);
                if (fq == 0 && row < MR) ssq[(size_t)row * 16 + u.pn * 4 + wc] = ss;
            }
    }
};
struct EpiUp {
    static constexpr bool PERM = true, AFTER_DRAIN = false, GSCALE = false;
    bf16_t* up;
    __device__ __forceinline__ void operator()(const f32x4 (&acc)[2][2][4][2], const Unit& u, int wr, int wc, int fr, int fq) const {
        const int colt = u.pn * 256 + wc * 32 + 8 * fq;
#pragma unroll
        for (int ai = 0; ai < 2; ++ai)
#pragma unroll
            for (int m = 0; m < 4; ++m) {
                const int row = u.pm * 256 + ai * 128 + wr * 64 + m * 16 + fr;
#pragma unroll
                for (int bj = 0; bj < 2; ++bj) {
                    const int col = colt + bj * 128;
                    f32x4 v0 = acc[ai][bj][m][0], v1 = acc[ai][bj][m][1];
#pragma unroll
                    for (int j = 0; j < 4; ++j) { const float a = fmaxf(v0[j], 0.f), b = fmaxf(v1[j], 0.f); v0[j] = a * a; v1[j] = b * b; }
                    u32x4 w; w.x = cvt_pk_bf16(v0[0], v0[1]); w.y = cvt_pk_bf16(v0[2], v0[3]); w.z = cvt_pk_bf16(v1[0], v1[1]); w.w = cvt_pk_bf16(v1[2], v1[3]);
                    *(u32x4*)(up + (size_t)row * DFF + col) = w;
                }
            }
    }
};

struct EpiResidNorm {
    static constexpr bool PERM = false, AFTER_DRAIN = true, GSCALE = false;
    float* out; const float* w; float* xbuf; unsigned* cnt;
    __device__ __forceinline__ void fused(f32x4 (&acc)[2][2][4][2], const Unit& u, int wr, int wc, int fr, int fq, LAS unsigned char* lds, int wid, int lane) const {
        LAS float* P = (LAS float*)lds;
        LAS float* S = (LAS float*)(lds + 4096);
        const int colt = u.pn * 256 + wc * 32 + 4 * fq;
#pragma unroll
        for (int ai = 0; ai < 2; ++ai)
#pragma unroll
            for (int m = 0; m < 4; ++m) {
                const int rl = ai * 128 + wr * 64 + m * 16 + fr;
                const float* brow = out + (size_t)(u.pm * 256 + rl) * 1024;
                float ss = 0.f;
#pragma unroll
                for (int bj = 0; bj < 2; ++bj)
#pragma unroll
                    for (int n = 0; n < 2; ++n) { const f32x4 o = *(const f32x4*)(brow + colt + bj * 128 + n * 16) + acc[ai][bj][m][n]; acc[ai][bj][m][n] = o;
                        ss += (o[0] * o[0] + o[1] * o[1]) + (o[2] * o[2] + o[3] * o[3]); }
                ss += __shfl_xor(ss, 16); ss += __shfl_xor(ss, 32);
                if (fq == 0) P[rl * 4 + wc] = ss;
            }
        __syncthreads();
        const int t = wid * 64 + lane;
        if (t < 256) {
            const float tot = (P[t * 4 + 0] + P[t * 4 + 1]) + (P[t * 4 + 2] + P[t * 4 + 3]);
            __hip_atomic_store(xbuf + (size_t)(u.pm * 256 + t) * 4 + u.pn, tot, __ATOMIC_RELAXED, __HIP_MEMORY_SCOPE_AGENT);
        }
        asm volatile("s_waitcnt vmcnt(0)" ::: "memory");
        __syncthreads();
        if (t == 0) {
            unsigned* c = cnt + 64 * u.pm;
            __hip_atomic_fetch_add(c, 1u, __ATOMIC_RELAXED, __HIP_MEMORY_SCOPE_AGENT);
            unsigned sp = 0;
            while (__hip_atomic_load(c, __ATOMIC_RELAXED, __HIP_MEMORY_SCOPE_AGENT) < 4u) { __builtin_amdgcn_s_sleep(1); if (++sp > (1u << 22)) break; }
            __builtin_amdgcn_fence(__ATOMIC_ACQUIRE, "agent");
            asm volatile("s_waitcnt vmcnt(0)" ::: "memory");
        }
        __syncthreads();
        if (t < 256) {
            const float* sl = xbuf + (size_t)(u.pm * 256 + t) * 4;
            const float a = __hip_atomic_load(sl + 0, __ATOMIC_RELAXED, __HIP_MEMORY_SCOPE_AGENT), b = __hip_atomic_load(sl + 1, __ATOMIC_RELAXED, __HIP_MEMORY_SCOPE_AGENT);
            const float c2 = __hip_atomic_load(sl + 2, __ATOMIC_RELAXED, __HIP_MEMORY_SCOPE_AGENT), d = __hip_atomic_load(sl + 3, __ATOMIC_RELAXED, __HIP_MEMORY_SCOPE_AGENT);
            S[t] = rsqrtf(((a + b) + (c2 + d)) * (1.f / 1024.f) + EPS);
        }
        __syncthreads();
#pragma unroll
        for (int ai = 0; ai < 2; ++ai)
#pragma unroll
            for (int m = 0; m < 4; ++m) {
                const int rl = ai * 128 + wr * 64 + m * 16 + fr;
                const float rs = S[rl];
                float* orow = out + (size_t)(u.pm * 256 + rl) * 1024;
#pragma unroll
                for (int bj = 0; bj < 2; ++bj)
#pragma unroll
                    for (int n = 0; n < 2; ++n) { const int col = colt + bj * 128 + n * 16; __builtin_nontemporal_store(acc[ai][bj][m][n] * rs * *(const f32x4*)(w + col), (f32x4*)(orow + col)); }
            }
    }
};
struct EpiResidNormH2 {
    static constexpr bool PERM = false, AFTER_DRAIN = true, GSCALE = false;
    const float* base; float* out; bf16_t* h2; const float* w; float* xbuf; unsigned* cnt;
    __device__ __forceinline__ void fused(f32x4 (&acc)[2][2][4][2], const Unit& u, int wr, int wc, int fr, int fq, LAS unsigned char* lds, int wid, int lane) const {
        LAS float* P = (LAS float*)lds;
        LAS float* S = (LAS float*)(lds + 4096);
        const int colt = u.pn * 256 + wc * 32 + 4 * fq;
#pragma unroll
        for (int ai = 0; ai < 2; ++ai)
#pragma unroll
            for (int m = 0; m < 4; ++m) {
                const int rl = ai * 128 + wr * 64 + m * 16 + fr;
                const size_t ro = (size_t)(u.pm * 256 + rl) * 1024;
                float ss = 0.f;
#pragma unroll
                for (int bj = 0; bj < 2; ++bj)
#pragma unroll
                    for (int n = 0; n < 2; ++n) { const int col = colt + bj * 128 + n * 16; const f32x4 o = *(const f32x4*)(base + ro + col) + acc[ai][bj][m][n]; acc[ai][bj][m][n] = o;
                        *(f32x4*)(out + ro + col) = o;
                        ss += (o[0] * o[0] + o[1] * o[1]) + (o[2] * o[2] + o[3] * o[3]); }
                ss += __shfl_xor(ss, 16); ss += __shfl_xor(ss, 32);
                if (fq == 0) P[rl * 4 + wc] = ss;
            }
        __syncthreads();
        const int t = wid * 64 + lane;
        if (t < 256) {
            const float tot = (P[t * 4 + 0] + P[t * 4 + 1]) + (P[t * 4 + 2] + P[t * 4 + 3]);
            __hip_atomic_store(xbuf + (size_t)(u.pm * 256 + t) * 4 + u.pn, tot, __ATOMIC_RELAXED, __HIP_MEMORY_SCOPE_AGENT);
        }
        asm volatile("s_waitcnt vmcnt(0)" ::: "memory");
        __syncthreads();
        if (t == 0) {
            unsigned* c = cnt + 64 * u.pm;
            __hip_atomic_fetch_add(c, 1u, __ATOMIC_RELAXED, __HIP_MEMORY_SCOPE_AGENT);
            unsigned sp = 0;
            while (__hip_atomic_load(c, __ATOMIC_RELAXED, __HIP_MEMORY_SCOPE_AGENT) < 4u) { __builtin_amdgcn_s_sleep(1); if (++sp > (1u << 22)) break; }
            __builtin_amdgcn_fence(__ATOMIC_ACQUIRE, "agent");
            asm volatile("s_waitcnt vmcnt(0)" ::: "memory");
        }
        __syncthreads();
        if (t < 256) {
            const float* sl = xbuf + (size_t)(u.pm * 256 + t) * 4;
            const float a = __hip_atomic_load(sl + 0, __ATOMIC_RELAXED, __HIP_MEMORY_SCOPE_AGENT), b = __hip_atomic_load(sl + 1, __ATOMIC_RELAXED, __HIP_MEMORY_SCOPE_AGENT);
            const float c2 = __hip_atomic_load(sl + 2, __ATOMIC_RELAXED, __HIP_MEMORY_SCOPE_AGENT), d = __hip_atomic_load(sl + 3, __ATOMIC_RELAXED, __HIP_MEMORY_SCOPE_AGENT);
            S[t] = rsqrtf(((a + b) + (c2 + d)) * (1.f / 1024.f) + EPS);
        }
        __syncthreads();
#pragma unroll
        for (int ai = 0; ai < 2; ++ai)
#pragma unroll
            for (int m = 0; m < 4; ++m) {
                const int rl = ai * 128 + wr * 64 + m * 16 + fr;
                const float rs = S[rl];
                bf16_t* hrow = h2 + (size_t)(u.pm * 256 + rl) * 1024;
#pragma unroll
                for (int bj = 0; bj < 2; ++bj)
#pragma unroll
                    for (int n = 0; n < 2; ++n) { const int col = colt + bj * 128 + n * 16; const f32x4 ww = *(const f32x4*)(w + col); const f32x4 o = acc[ai][bj][m][n];
                        u32x2 pk; pk.x = cvt_pk_bf16(o[0] * rs * ww[0], o[1] * rs * ww[1]); pk.y = cvt_pk_bf16(o[2] * rs * ww[2], o[3] * rs * ww[3]);
                        *(u32x2*)(hrow + col) = pk; }
            }
    }
};
__device__ __forceinline__ int map_win_col(int j) {
    if (j < 6144) return j;
    if (j < 9216) return j + 32;
    if (j < 11264) return j + 48;
    if (j < 11296) return j - 11264 + 6144;
    if (j < 11304) return j - 11296 + 9248;
    if (j < 11312) return j - 11304 + 9256;
    return -1;
}
struct TWTile { const float* src; bf16_t* dst; const float* ks; int K, Nsrc, k0, n0; float scale; int mode; };
constexpr int TW_WIN = 16 * 90, TW_WUP = 16 * 32, TW_WDN = 64 * 8, TW_WA = 32 * 8, TW_WB = 16 * 8, TW_WO = 16 * 8, TW_WQ = 16, TW_WK = 16;
constexpr int TW_TOTAL = TW_WIN + TW_WUP + TW_WDN + TW_WA + TW_WB + TW_WO + TW_WQ + TW_WK;
__device__ __forceinline__ void tw_get(const Params& p, int g, TWTile& t) {
    unsigned char* ws = p.ws; int nkb; t.scale = 1.f; t.mode = 0; t.ks = nullptr;
    if (g < TW_WIN) { t.src = p.w_in; t.dst = (bf16_t*)(ws + WS_WIN); t.K = 1024; t.Nsrc = 11312; t.mode = 1; nkb = 16; }
    else if ((g -= TW_WIN) < TW_WUP) { t.src = p.w_up; t.dst = (bf16_t*)(ws + WS_WUP); t.K = 1024; t.Nsrc = 4096; nkb = 16; }
    else if ((g -= TW_WUP) < TW_WDN) { t.src = p.w_down; t.dst = (bf16_t*)(ws + WS_WDN); t.K = 4096; t.Nsrc = 1024; nkb = 64; }
    else if ((g -= TW_WDN) < TW_WA) { t.src = p.w_a; t.dst = (bf16_t*)(ws + WS_WA); t.K = 2048; t.Nsrc = 1024; nkb = 32; t.ks = p.m_nw; }
    else if ((g -= TW_WA) < TW_WB) { t.src = p.w_b; t.dst = (bf16_t*)(ws + WS_WB); t.K = 1024; t.Nsrc = 1024; nkb = 16; }
    else if ((g -= TW_WB) < TW_WO) { t.src = p.w_o; t.dst = (bf16_t*)(ws + WS_WO); t.K = 1024; t.Nsrc = 1024; nkb = 16; }
    else if ((g -= TW_WO) < TW_WQ) { const int h = g >> 1; g &= 1; t.src = p.wq + h * 16384; t.dst = (bf16_t*)(ws + WS_WQ) + h * 16384; t.K = 128; t.Nsrc = 128; nkb = 2; }
    else { g -= TW_WQ; const int h = g >> 1; g &= 1; t.src = p.wk + h * 16384; t.dst = (bf16_t*)(ws + WS_WK) + h * 16384; t.K = 128; t.Nsrc = 128; nkb = 2; t.scale = 0.08838834764831845f; }
    t.k0 = (g % nkb) * 64; t.n0 = (g / nkb) * 128;
}
__device__ __forceinline__ void tw_load(const TWTile& t, int tid, f32x4 (&v)[4]) {
#pragma unroll
    for (int i = 0; i < 4; ++i) { const int idx = tid + 512 * i, kk = idx >> 5, n = t.n0 + 4 * (idx & 31);
        const int sc = t.mode == 1 ? map_win_col(n) : n;
        v[i] = sc >= 0 ? *(const f32x4*)(t.src + (size_t)(t.k0 + kk) * t.Nsrc + sc) : (f32x4){0.f, 0.f, 0.f, 0.f}; }
}
__device__ void transpose_all(const Params& p, LAS float* scr) {
    int tid_ = threadIdx.x; asm volatile("" : "+v"(tid_));
    const int tid = tid_;
    int g = blockIdx.x;
    if (g >= TW_TOTAL) return;
    TWTile cur; f32x4 v[4];
    tw_get(p, g, cur); tw_load(cur, tid, v);
    for (;;) {
#pragma unroll
        for (int i = 0; i < 4; ++i) { const int idx = tid + 512 * i, kk = idx >> 5, nl4 = 4 * (idx & 31); LAS float* d = scr + kk * 129 + nl4;
            const float sc_ = cur.ks ? cur.scale * cur.ks[cur.k0 + kk] : cur.scale;
            d[0] = v[i][0] * sc_; d[1] = v[i][1] * sc_; d[2] = v[i][2] * sc_; d[3] = v[i][3] * sc_; }
        const int gn = g + gridDim.x; const bool more = gn < TW_TOTAL;
        TWTile nxt;
        if (more) { tw_get(p, gn, nxt); tw_load(nxt, tid, v); }
        __syncthreads();
        {
            const int nl = tid >> 2, ks = (tid & 3) * 16;
            u32x4 o0, o1;
            const LAS float* s = scr + ks * 129 + nl;
            o0.x = cvt_pk_bf16(s[0 * 129], s[1 * 129]); o0.y = cvt_pk_bf16(s[2 * 129], s[3 * 129]); o0.z = cvt_pk_bf16(s[4 * 129], s[5 * 129]); o0.w = cvt_pk_bf16(s[6 * 129], s[7 * 129]);
            o1.x = cvt_pk_bf16(s[8 * 129], s[9 * 129]); o1.y = cvt_pk_bf16(s[10 * 129], s[11 * 129]); o1.z = cvt_pk_bf16(s[12 * 129], s[13 * 129]); o1.w = cvt_pk_bf16(s[14 * 129], s[15 * 129]);
            bf16_t* d = cur.dst + (size_t)(cur.n0 + nl) * cur.K + cur.k0 + ks;
            *(u32x4*)d = o0; *(u32x4*)(d + 8) = o1;
        }
        __syncthreads();
        if (!more) break;
        cur = nxt; g = gn;
    }
}
__device__ __forceinline__ void rms_row_bf16(const float* xr, float rs_in, bool have_rs, const float* w, bf16_t* orow, int lane) {
    f32x4 v[4]; float s = 0.f;
#pragma unroll
    for (int j = 0; j < 4; ++j) { v[j] = *(const f32x4*)(xr + lane * 4 + 256 * j); s += (v[j][0] * v[j][0] + v[j][1] * v[j][1]) + (v[j][2] * v[j][2] + v[j][3] * v[j][3]); }
    const float rs = have_rs ? rs_in : rsqrtf(wave_sum(s) * (1.f / 1024.f) + EPS);
#pragma unroll
    for (int j = 0; j < 4; ++j) { const f32x4 ww = *(const f32x4*)(w + lane * 4 + 256 * j);
        u32x2 o; o.x = cvt_pk_bf16(v[j][0] * rs * ww[0], v[j][1] * rs * ww[1]); o.y = cvt_pk_bf16(v[j][2] * rs * ww[2], v[j][3] * rs * ww[3]);
        *(u32x2*)(orow + lane * 4 + 256 * j) = o; }
}

__device__ void phase_prep(const Params& p, LAS unsigned char* lds) {
    LAS float* scr = (LAS float*)lds;
    unsigned char* ws = p.ws;
    transpose_all(p, scr);
    int tid_ = threadIdx.x; asm volatile("" : "+v"(tid_));
    const int tid = tid_, lane = tid & 63, wid = __builtin_amdgcn_readfirstlane(tid >> 6);
    bf16_t* xn = (bf16_t*)(ws + WS_XN);
    for (int row = blockIdx.x * 8 + wid; row < MPAD; row += gridDim.x * 8) {
        if (row >= MR) { for (int j = 0; j < 4; ++j) *(u32x2*)(xn + (size_t)row * 1024 + lane * 4 + 256 * j) = (u32x2){0u, 0u}; }
        else { const float* xr = row < MP ? p.x_prompt + (size_t)row * 1024 : p.x_sample + (size_t)(row - MP) * 1024; rms_row_bf16(xr, 0.f, false, p.nmix, xn + (size_t)row * 1024, lane); }
    }
    const size_t gs = (size_t)gridDim.x * 512, g0 = (size_t)blockIdx.x * 512 + tid;
    for (size_t i = g0; i < (size_t)128 * 2 * 4096; i += gs) { const size_t s = i / 8192, r = i % 8192; p.out[OFF_S_MCONV + s * 12288 + r] = p.st_mconv[s * 12288 + 4096 + r]; }
    for (size_t i = g0; i < (size_t)128 * 2 * 1024; i += gs) { const size_t s = i / 2048, r = i % 2048; p.out[OFF_S_LCONV + s * 3072 + r] = p.st_lconv[s * 3072 + 1024 + r]; }
}

constexpr int SQ = 136, SK = 72;
constexpr int L_Q = 0, L_K = 17408, L_KWT = 34816, L_VT = 53248, L_ST = 73984, L_TOK = 113152, L_IO = 115712, L_UC = 133120;
#define MFMA16(a, b, c) __builtin_amdgcn_mfma_f32_16x16x32_bf16(a, b, c, 0, 0, 0)
__device__ __forceinline__ bf16x8 ldfrag(const LAS bf16_t* base, int row, int stride, int k0) { return *(const LAS bf16x8*)(base + row * stride + k0); }

__device__ __forceinline__ void scan_qk(LAS unsigned char* lds, int wid, int l15, int lq) {
    const LAS bf16_t* Q = (const LAS bf16_t*)(lds + L_Q); const LAS bf16_t* K = (const LAS bf16_t*)(lds + L_K);
    LAS bf16_t* WGT = (LAS bf16_t*)(lds + L_UC);
    const LAS float* AL = (const LAS float*)(lds + L_TOK); const LAS float* BE = AL + 64; const LAS float* GA = AL + 128;
    const int sb = wid >> 1;
#pragma unroll
    for (int j = 0; j < 2; ++j) {
        const int rb = (wid & 1) * 2 + j; f32x4 qk = (f32x4){0.f, 0.f, 0.f, 0.f};
        if (rb <= sb) {
#pragma unroll
            for (int ks = 0; ks < 4; ++ks) qk = MFMA16(ldfrag(Q, sb * 16 + l15, SQ, ks * 32 + 8 * lq), ldfrag(K, rb * 16 + l15, SQ, ks * 32 + 8 * lq), qk);
        }
        const int r = rb * 16 + l15; const float be = BE[r], ga = GA[r];
#pragma unroll
        for (int i = 0; i < 4; ++i) { const int s = sb * 16 + lq * 4 + i; const float w = (r <= s) ? qk[i] * __expf(AL[s] + be) * ga : 0.f; WGT[s * SK + r] = f2bf(w); }
    }
    __syncthreads();
}
struct OutFrags { bf16x8 q[4], w[2]; };
__device__ __forceinline__ void scan_out_frags(LAS unsigned char* lds, int sb, int l15, int lq, OutFrags& f) {
    const LAS bf16_t* Q = (const LAS bf16_t*)(lds + L_Q); const LAS bf16_t* WGT = (const LAS bf16_t*)(lds + L_UC);
#pragma unroll
    for (int ks = 0; ks < 4; ++ks) f.q[ks] = ldfrag(Q, sb * 16 + l15, SQ, ks * 32 + 8 * lq);
#pragma unroll
    for (int ks = 0; ks < 2; ++ks) f.w[ks] = ldfrag(WGT, sb * 16 + l15, SK, ks * 32 + 8 * lq);
}
__device__ __forceinline__ f32x4 scan_out_tile(LAS unsigned char* lds, const OutFrags& f, int sb, int vb, int l15, int lq) {
    const LAS bf16_t* VT = (const LAS bf16_t*)(lds + L_VT); const LAS bf16_t* ST = (const LAS bf16_t*)(lds + L_ST);
    const LAS float* SG = (const LAS float*)(lds + L_TOK) + 192;
    bf16x8 bs[4], bv[2];
#pragma unroll
    for (int ks = 0; ks < 4; ++ks) bs[ks] = ldfrag(ST, vb * 16 + l15, SQ, ks * 32 + 8 * lq);
#pragma unroll
    for (int ks = 0; ks < 2; ++ks) bv[ks] = ldfrag(VT, vb * 16 + l15, SK, ks * 32 + 8 * lq);
    f32x4 o = (f32x4){0.f, 0.f, 0.f, 0.f};
#pragma unroll
    for (int ks = 0; ks < 4; ++ks) o = MFMA16(f.q[ks], bs[ks], o);
#pragma unroll
    for (int i = 0; i < 4; ++i) o[i] *= SG[sb * 16 + lq * 4 + i];
#pragma unroll
    for (int ks = 0; ks < 2; ++ks) o = MFMA16(f.w[ks], bv[ks], o);
    return o;
}
struct StateFrags { bf16x8 k[2]; float kap; };
__device__ __forceinline__ void scan_state_frags(LAS unsigned char* lds, int kb, int l15, int lq, StateFrags& f) {
    const LAS bf16_t* KWT = (const LAS bf16_t*)(lds + L_KWT);
#pragma unroll
    for (int ks = 0; ks < 2; ++ks) f.k[ks] = ldfrag(KWT, kb * 16 + l15, SK, ks * 32 + 8 * lq);
    f.kap = ((const LAS float*)(lds + L_TOK))[576];
}
__device__ __forceinline__ void scan_state_tile(LAS unsigned char* lds, const StateFrags& f, f32x4& st, int vb, int kb, int l15, int lq) {
    const LAS bf16_t* VT = (const LAS bf16_t*)(lds + L_VT);
    LAS bf16_t* ST = (LAS bf16_t*)(lds + L_ST);
    bf16x8 av[2];
#pragma unroll
    for (int ks = 0; ks < 2; ++ks) av[ks] = ldfrag(VT, vb * 16 + l15, SK, ks * 32 + 8 * lq);
#pragma unroll
    for (int i = 0; i < 4; ++i) st[i] *= f.kap;
#pragma unroll
    for (int ks = 0; ks < 2; ++ks) st = MFMA16(av[ks], f.k[ks], st);
#pragma unroll
    for (int i = 0; i < 4; ++i) ST[(vb * 16 + lq * 4 + i) * SQ + kb * 16 + l15] = f2bf(st[i]);
}

__device__ void ssd_unit(const Params& p, LAS unsigned char* lds, int b, int h) {
    int tid_ = threadIdx.x; asm volatile("" : "+v"(tid_));
    const int tid = tid_, lane = tid & 63, wid = __builtin_amdgcn_readfirstlane(tid >> 6), l15 = lane & 15, lq = lane >> 4;
    const int g = h >> 2, sb = wid >> 1;
    bf16_t* proj = (bf16_t*)(p.ws + WS_PROJ);
    const float* gates = (const float*)(p.ws + WS_GATES);
    float* gssq = (float*)(p.ws + WS_GSSQ);
    LAS bf16_t* Q = (LAS bf16_t*)(lds + L_Q); LAS bf16_t* K = (LAS bf16_t*)(lds + L_K); LAS bf16_t* KWT = (LAS bf16_t*)(lds + L_KWT);
    LAS bf16_t* VT = (LAS bf16_t*)(lds + L_VT);
    LAS bf16_t* ZS = (LAS bf16_t*)(lds + L_IO);
    LAS float* TOK = (LAS float*)(lds + L_TOK);
    const float A_h = -__expf(p.A_log[h]), dtb = p.dt_bias[h], Dh = p.Dskip[h];
    __syncthreads();
    for (int i = tid; i < 39168 / 4; i += 512) ((LAS unsigned*)(lds + L_ST))[i] = 0u;
    f32x4 st[4];
#pragma unroll
    for (int v = 0; v < 4; ++v) st[v] = (f32x4){0.f, 0.f, 0.f, 0.f};
    int chn[5]; float cw[5][4], cb[5];
    chn[0] = h * 64 + lane; chn[1] = 2048 + g * 128 + lane; chn[2] = chn[1] + 64; chn[3] = 3072 + g * 128 + lane; chn[4] = chn[3] + 64;
#pragma unroll
    for (int q = 0; q < 5; ++q) { cb[q] = p.m_cb[chn[q]];
#pragma unroll
        for (int j = 0; j < 4; ++j) cw[q][j] = p.m_cw[j * 4096 + chn[q]]; }
    const size_t rowb = (size_t)b * TSEQ;
    unsigned rawp[5][6]; float dtr_n; u32x4 zt_n;
    const int zr_ = tid >> 3, zs_ = tid & 7;
    const bf16_t* projc = proj;
#define SSD_ISSUE(cc) do { const int t0n = (cc) * 64; const int tb_ = t0n + 8 * wid - 3; \
        _Pragma("unroll") for (int q = 0; q < 5; ++q) { const bf16_t* bq_ = projc + pidx(rowb, XBC_OFF + chn[q]) + (long)tb_ * 64; \
            _Pragma("unroll") for (int j = 0; j < 12; j += 2) { unsigned lo_ = bq_[j * 64]; unsigned hi_ = (j + 1 < 11) ? (unsigned)bq_[(j + 1) * 64] : 0u; \
                if (tb_ + j < 0) lo_ = 0u; if (tb_ + j + 1 < 0) hi_ = 0u; rawp[q][j >> 1] = lo_ | (hi_ << 16); } } \
        dtr_n = gates[(rowb + t0n + lane) * 64 + h]; \
        zt_n = __builtin_nontemporal_load((const u32x4*)(projc + pidx(rowb + t0n + zr_, Z_OFF + h * 64 + zs_ * 8))); } while (0)
    SSD_ISSUE(0);
    for (int c = 0; c < 32; ++c) {
        const int t0 = c * 64;
        if (wid == 0) {
            const float dtr = dtr_n;
            const float dt = softplus(dtr + dtb);
            float ac = dt * A_h;
#pragma unroll
            for (int o = 1; o < 64; o <<= 1) { const float t = __shfl_up(ac, o); if (lane >= o) ac += t; }
            const float aL = __shfl(ac, 63);
            TOK[lane] = ac; TOK[64 + lane] = -ac; TOK[128 + lane] = dt; TOK[192 + lane] = __expf(ac); TOK[256 + lane] = __expf(aL - ac) * dt;
            if (lane == 0) TOK[576] = __expf(aL);
        }
        __syncthreads();
        *(LAS u32x4*)(ZS + zr_ * SK + zs_ * 8) = zt_n;
#pragma unroll
        for (int q = 0; q < 5; ++q) {
            float r[11];
#pragma unroll
            for (int j = 0; j < 11; ++j) r[j] = (j & 1) ? bfhi(rawp[q][j >> 1]) : bflo(rawp[q][j >> 1]);
            float y[8];
#pragma unroll
            for (int i = 0; i < 8; ++i) y[i] = silu(cb[q] + r[i] * cw[q][0] + r[i + 1] * cw[q][1] + r[i + 2] * cw[q][2] + r[i + 3] * cw[q][3]);
            if (q == 0) {
                u32x4 w; w.x = cvt_pk_bf16(y[0], y[1]); w.y = cvt_pk_bf16(y[2], y[3]); w.z = cvt_pk_bf16(y[4], y[5]); w.w = cvt_pk_bf16(y[6], y[7]);
                *(LAS u32x4*)(VT + lane * SK + 8 * wid) = w;
            } else if (q <= 2) {
                const int n = (q - 1) * 64 + lane;
                float yw[8];
#pragma unroll
                for (int i = 0; i < 8; ++i) { K[(8 * wid + i) * SQ + n] = f2bf(y[i]); yw[i] = y[i] * TOK[256 + 8 * wid + i]; }
                u32x4 w; w.x = cvt_pk_bf16(yw[0], yw[1]); w.y = cvt_pk_bf16(yw[2], yw[3]); w.z = cvt_pk_bf16(yw[4], yw[5]); w.w = cvt_pk_bf16(yw[6], yw[7]);
                *(LAS u32x4*)(KWT + n * SK + 8 * wid) = w;
            } else {
                const int n = (q - 3) * 64 + lane;
#pragma unroll
                for (int i = 0; i < 8; ++i) Q[(8 * wid + i) * SQ + n] = f2bf(y[i]);
            }
        }
        if (c < 31) SSD_ISSUE(c + 1);
        __syncthreads();
        scan_qk(lds, wid, l15, lq);
        float ss[4] = {0.f, 0.f, 0.f, 0.f};
        {
            f32x4 oo[2];
            OutFrags of; scan_out_frags(lds, sb, l15, lq, of);
#pragma unroll
            for (int j = 0; j < 2; ++j) oo[j] = scan_out_tile(lds, of, sb, (wid & 1) * 2 + j, l15, lq);
#pragma unroll
            for (int j = 0; j < 2; ++j) {
                const int vb = (wid & 1) * 2 + j, pch = vb * 16 + l15;
#pragma unroll
                for (int i = 0; i < 4; ++i) {
                    const int s = sb * 16 + lq * 4 + i;
                    const float xv = bf2f(VT[pch * SK + s]);
                    const float y = (oo[j][i] + Dh * xv) * silu(bf2f(ZS[s * SK + pch]));
                    ZS[s * SK + pch] = f2bf(y);
                    ss[i] += y * y;
                }
            }
        }
#pragma unroll
        for (int i = 0; i < 4; ++i) { float v = ss[i]; v += __shfl_xor(v, 1); v += __shfl_xor(v, 2); v += __shfl_xor(v, 4); v += __shfl_xor(v, 8); if (l15 == 0) TOK[448 + (wid & 1) * 64 + sb * 16 + lq * 4 + i] = v; }
        __syncthreads();
        StateFrags sf; scan_state_frags(lds, wid, l15, lq, sf);
#pragma unroll
        for (int v = 0; v < 4; ++v) scan_state_tile(lds, sf, st[v], v, wid, l15, lq);
        {
            __builtin_nontemporal_store(*(const LAS u32x4*)(ZS + zr_ * SK + zs_ * 8), (u32x4*)((bf16_t*)p.out + (rowb + t0 + zr_) * 2048 + h * 64 + zs_ * 8));
        }
        if (tid < 64) gssq[(rowb + t0 + tid) * 32 + h] = TOK[448 + tid] + TOK[512 + tid];
        __syncthreads();
    }
    float* so = p.out + OFF_P_SSM + ((size_t)(b * 32 + h) * 64) * 128;
#pragma unroll
    for (int v = 0; v < 4; ++v)
#pragma unroll
        for (int i = 0; i < 4; ++i) so[(size_t)(v * 16 + lq * 4 + i) * 128 + wid * 16 + l15] = st[v][i];
}

__device__ void mlstm_unit(const Params& p, LAS unsigned char* lds, int b, int h) {
    int tid_ = threadIdx.x; asm volatile("" : "+v"(tid_));
    const int tid = tid_, lane = tid & 63, wid = __builtin_amdgcn_readfirstlane(tid >> 6), l15 = lane & 15, lq = lane >> 4;
    const int sb = wid >> 1;
    bf16_t* proj = (bf16_t*)(p.ws + WS_PROJ);
    const float* gates = (const float*)(p.ws + WS_GATES);
    const bf16_t* WQT = (const bf16_t*)(p.ws + WS_WQ) + h * 16384;
    const bf16_t* WKT = (const bf16_t*)(p.ws + WS_WK) + h * 16384;
    LAS bf16_t* Q = (LAS bf16_t*)(lds + L_Q); LAS bf16_t* K = (LAS bf16_t*)(lds + L_K); LAS bf16_t* KWT = (LAS bf16_t*)(lds + L_KWT);
    LAS bf16_t* UC = (LAS bf16_t*)(lds + L_UC);
    LAS bf16_t* OS = (LAS bf16_t*)(lds + L_IO);
    LAS bf16_t* VT = (LAS bf16_t*)(lds + L_VT);
    LAS float* TOK = (LAS float*)(lds + L_TOK);
    const float ib = p.i_b[h], fb = p.f_b[h];
    __syncthreads();
    for (int i = tid; i < 39168 / 4; i += 512) ((LAS unsigned*)(lds + L_ST))[i] = 0u;
    for (int i = tid; i < 16 * SK; i += 512) VT[128 * SK + i] = (i < 64) ? (bf16_t)0x3F80u : (bf16_t)0u;
    f32x4 st[9];
#pragma unroll
    for (int v = 0; v < 9; ++v) st[v] = (f32x4){0.f, 0.f, 0.f, 0.f};
    float m0 = 0.f;
    int chn[2]; float cw[2][4], cb[2];
    chn[0] = h * 128 + lane; chn[1] = chn[0] + 64;
#pragma unroll
    for (int q = 0; q < 2; ++q) { cb[q] = p.l_cb[chn[q]];
#pragma unroll
        for (int j = 0; j < 4; ++j) cw[q][j] = p.l_cw[j * 1024 + chn[q]]; }
    const size_t rowb = (size_t)b * TSEQ;
    unsigned rawu[2][6], rawvv[2][4]; float ig_n, fg_n; u32x4 ot_n[2];
    const bf16_t* projc = proj;
#define ML_ISSUE(cc) do { const int t0n = (cc) * 64; const int tb_ = t0n + 8 * wid - 3; \
        _Pragma("unroll") for (int q = 0; q < 2; ++q) { const bf16_t* bq_ = projc + pidx(rowb, U_OFF + chn[q]) + (long)tb_ * 64; \
            _Pragma("unroll") for (int j = 0; j < 12; j += 2) { unsigned lo_ = __builtin_nontemporal_load(bq_ + j * 64); unsigned hi_ = (j + 1 < 11) ? (unsigned)__builtin_nontemporal_load(bq_ + (j + 1) * 64) : 0u; \
                if (tb_ + j < 0) lo_ = 0u; if (tb_ + j + 1 < 0) hi_ = 0u; rawu[q][j >> 1] = lo_ | (hi_ << 16); } \
            const bf16_t* bv_ = projc + pidx(rowb + t0n + 8 * wid, V_OFF + chn[q]); \
            _Pragma("unroll") for (int i = 0; i < 8; i += 2) rawvv[q][i >> 1] = (unsigned)__builtin_nontemporal_load(bv_ + i * 64) | ((unsigned)__builtin_nontemporal_load(bv_ + (i + 1) * 64) << 16); } \
        ig_n = gates[(rowb + t0n + lane) * 64 + 32 + h]; fg_n = gates[(rowb + t0n + lane) * 64 + 40 + h]; \
        _Pragma("unroll") for (int k2 = 0; k2 < 2; ++k2) { const int idx = tid + 512 * k2, r_ = idx >> 4, sg_ = idx & 15; \
            ot_n[k2] = __builtin_nontemporal_load((const u32x4*)(projc + pidx(rowb + t0n + r_, O_OFF + h * 128 + sg_ * 8))); } } while (0)
    ML_ISSUE(0);
    for (int c = 0; c < 32; ++c) {
        const int t0 = c * 64;
        if (wid == 0) {
            const float ig = ig_n + ib;
            const float lf = logsigm(fg_n + fb);
            float bc = lf;
#pragma unroll
            for (int o = 1; o < 64; o <<= 1) { const float t = __shfl_up(bc, o); if (lane >= o) bc += t; }
            const float gg = ig - bc;
            float cm = gg;
#pragma unroll
            for (int o = 1; o < 64; o <<= 1) { const float t = __shfl_up(cm, o); if (lane >= o) cm = fmaxf(cm, t); }
            const float M = fmaxf(m0, cm);
            const float ML = __shfl(M, 63), bL = __shfl(bc, 63);
            TOK[lane] = -M; TOK[64 + lane] = gg; TOK[128 + lane] = 1.f; TOK[192 + lane] = __expf(m0 - M); TOK[256 + lane] = __expf(gg - ML); TOK[320 + lane] = bc + M;
            if (lane == 0) TOK[576] = __expf(m0 - ML);
            m0 = bL + ML;
        }
#pragma unroll
        for (int k2 = 0; k2 < 2; ++k2) {
            const int idx = tid + 512 * k2, r_ = idx >> 4, sg_ = idx & 15;
            if (c > 0) __builtin_nontemporal_store(*(const LAS u32x4*)(OS + r_ * SQ + sg_ * 8), (u32x4*)((bf16_t*)(p.ws + WS_XN) + (rowb + t0 - 64 + r_) * 1024 + h * 128 + sg_ * 8));
            *(LAS u32x4*)(OS + r_ * SQ + sg_ * 8) = ot_n[k2];
        }
#pragma unroll
        for (int q = 0; q < 2; ++q) {
            float r[11];
#pragma unroll
            for (int j = 0; j < 11; ++j) r[j] = (j & 1) ? bfhi(rawu[q][j >> 1]) : bflo(rawu[q][j >> 1]);
#pragma unroll
            for (int i = 0; i < 8; ++i) UC[(8 * wid + i) * SQ + q * 64 + lane] = f2bf(silu(cb[q] + r[i] * cw[q][0] + r[i + 1] * cw[q][1] + r[i + 2] * cw[q][2] + r[i + 3] * cw[q][3]));
            u32x4 w; w.x = rawvv[q][0]; w.y = rawvv[q][1]; w.z = rawvv[q][2]; w.w = rawvv[q][3];
            *(LAS u32x4*)(VT + (q * 64 + lane) * SK + 8 * wid) = w;
        }
        bf16x8 wb[2][8];
#define ML_WLOAD(buf, jj) do { const int e_ = ((wid & 1) * 4 + (jj)) * 16 + l15; \
        _Pragma("unroll") for (int ks = 0; ks < 4; ++ks) { wb[buf][2 * ks] = *(const bf16x8*)(WQT + e_ * 128 + ks * 32 + 8 * lq); wb[buf][2 * ks + 1] = *(const bf16x8*)(WKT + e_ * 128 + ks * 32 + 8 * lq); } } while (0)
        ML_WLOAD(0, 0); ML_WLOAD(1, 1);
        __syncthreads();
        {
            f32x4 qa[4], ka[4];
            bf16x8 af[4];
#pragma unroll
            for (int ks = 0; ks < 4; ++ks) af[ks] = ldfrag(UC, sb * 16 + l15, SQ, ks * 32 + 8 * lq);
#pragma unroll
            for (int j = 0; j < 4; ++j) {
                qa[j] = (f32x4){0.f, 0.f, 0.f, 0.f}; ka[j] = qa[j];
#pragma unroll
                for (int ks = 0; ks < 4; ++ks) { qa[j] = MFMA16(af[ks], wb[j & 1][2 * ks], qa[j]); ka[j] = MFMA16(af[ks], wb[j & 1][2 * ks + 1], ka[j]); }
                asm volatile("" ::: "memory");
                if (j < 2) ML_WLOAD(j & 1, j + 2);
                asm volatile("" ::: "memory");
            }
#pragma unroll
            for (int j = 0; j < 4; ++j) {
                const int e = ((wid & 1) * 4 + j) * 16 + l15, r0 = sb * 16 + lq * 4;
#pragma unroll
                for (int i = 0; i < 4; ++i) { Q[(r0 + i) * SQ + e] = f2bf(qa[j][i]); K[(r0 + i) * SQ + e] = f2bf(ka[j][i]); }
                u32x2 w; w.x = cvt_pk_bf16(ka[j][0] * TOK[256 + r0], ka[j][1] * TOK[256 + r0 + 1]); w.y = cvt_pk_bf16(ka[j][2] * TOK[256 + r0 + 2], ka[j][3] * TOK[256 + r0 + 3]);
                *(LAS u32x2*)(KWT + e * SK + r0) = w;
            }
        }
        if (c < 31) ML_ISSUE(c + 1);
        __syncthreads();
        scan_qk(lds, wid, l15, lq);
        OutFrags of; scan_out_frags(lds, sb, l15, lq, of);
        f32x4 o[5];
#pragma unroll
        for (int j = 0; j < 5; ++j) { const int vb = (wid & 1) * 5 + j; o[j] = (f32x4){0.f, 0.f, 0.f, 0.f}; if (vb < 9) o[j] = scan_out_tile(lds, of, sb, vb, l15, lq); }
        if ((wid & 1) && l15 == 0) {
#pragma unroll
            for (int i = 0; i < 4; ++i) TOK[384 + sb * 16 + lq * 4 + i] = o[3][i];
        }
        {
            float ss[4] = {0.f, 0.f, 0.f, 0.f};
#pragma unroll
            for (int i = 0; i < 4; ++i)
#pragma unroll
                for (int j = 0; j < 5; ++j) { const int vb = (wid & 1) * 5 + j; if (vb < 8) ss[i] += o[j][i] * o[j][i]; }
#pragma unroll
            for (int i = 0; i < 4; ++i) { float v = ss[i]; v += __shfl_xor(v, 1); v += __shfl_xor(v, 2); v += __shfl_xor(v, 4); v += __shfl_xor(v, 8); if (l15 == 0) TOK[448 + (wid & 1) * 64 + sb * 16 + lq * 4 + i] = v; }
        }
        float lnw[5];
#pragma unroll
        for (int j = 0; j < 5; ++j) { const int vb = (wid & 1) * 5 + j; lnw[j] = (vb < 8) ? p.l_nw[h * 128 + vb * 16 + l15] : 0.f; }
        __syncthreads();
#pragma unroll
        for (int i = 0; i < 4; ++i) {
            const int s = sb * 16 + lq * 4 + i;
            const float dn = __builtin_amdgcn_rcpf(fmaxf(fabsf(TOK[384 + s]), __expf(-TOK[320 + s])));
            const float rs = rsqrtf((TOK[448 + s] + TOK[512 + s]) * dn * dn * (1.f / 128.f) + EPS) * dn;
#pragma unroll
            for (int j = 0; j < 5; ++j) { const int vb = (wid & 1) * 5 + j; if (vb < 8) {
                const int e = vb * 16 + l15;
                OS[s * SQ + e] = f2bf(o[j][i] * rs * lnw[j] * sigm(bf2f(OS[s * SQ + e])));
            } }
        }
        StateFrags sf; scan_state_frags(lds, wid, l15, lq, sf);
#pragma unroll
        for (int v = 0; v < 9; ++v) scan_state_tile(lds, sf, st[v], v, wid, l15, lq);
        __syncthreads();
    }
#pragma unroll
    for (int k2 = 0; k2 < 2; ++k2) {
        const int idx = tid + 512 * k2, r_ = idx >> 4, sg_ = idx & 15;
        *(u32x4*)((bf16_t*)(p.ws + WS_XN) + (rowb + 31 * 64 + r_) * 1024 + h * 128 + sg_ * 8) = *(const LAS u32x4*)(OS + r_ * SQ + sg_ * 8);
    }
    float* Co = p.out + OFF_P_C + (size_t)(b * 8 + h) * 16384;
    const int d = wid * 16 + l15;
#pragma unroll
    for (int v = 0; v < 8; ++v) *(f32x4*)(Co + (size_t)d * 128 + v * 16 + lq * 4) = st[v];
    if (lq == 0) p.out[OFF_P_N + (size_t)(b * 8 + h) * 128 + d] = st[8][0];
    if (tid == 0) p.out[OFF_P_M + b * 8 + h] = m0;
}

__device__ void ssd_sample_unit(const Params& p, LAS unsigned char* lds, int s, int g) {
    int tid_ = threadIdx.x; asm volatile("" : "+v"(tid_));
    const int tid = tid_, lane = tid & 63, wid = __builtin_amdgcn_readfirstlane(tid >> 6);
    bf16_t* proj = (bf16_t*)(p.ws + WS_PROJ);
    const float* gates = (const float*)(p.ws + WS_GATES);
    LAS float* F = (LAS float*)lds;
    const size_t row = (size_t)MP + s;
    const size_t sbase = (((size_t)s * 32 + g * 4) * 64 + wid * 32) * 128 + 2 * lane;
    float2 hv[32];
#pragma unroll
    for (int j = 0; j < 32; ++j) { const f32x2v t_ = __builtin_nontemporal_load((const f32x2v*)(p.st_ssm + sbase + (size_t)j * 128)); hv[j].x = t_[0]; hv[j].y = t_[1]; }
    __syncthreads();
    {
        const int ch = tid < 256 ? g * 256 + tid : (tid < 384 ? 2048 + g * 128 + (tid - 256) : 3072 + g * 128 + (tid - 384));
        float y = p.m_cb[ch];
#pragma unroll
        for (int j = 0; j < 3; ++j) y += p.st_mconv[((size_t)s * 3 + j) * 4096 + ch] * p.m_cw[j * 4096 + ch];
        y += p.out[OFF_S_MCONV + ((size_t)s * 3 + 2) * 4096 + ch] * p.m_cw[3 * 4096 + ch];
        F[tid] = silu(y);
        if (tid < 4) { const int h = g * 4 + tid; const float dt = softplus(gates[row * 64 + h] + p.dt_bias[h]); F[776 + tid] = dt; F[780 + tid] = __expf(-dt * __expf(p.A_log[h])); }
    }
    __syncthreads();
    const float Bn0 = F[256 + 2 * lane], Bn1 = F[257 + 2 * lane], Cn0 = F[384 + 2 * lane], Cn1 = F[385 + 2 * lane];
    {
        const int hh = wid >> 1;
        const float dt = F[776 + hh], dA = F[780 + hh];
#pragma unroll
        for (int j = 0; j < 32; ++j) { const int rr = wid * 32 + j;
            const float xv = F[rr];
            float2 hn; hn.x = dA * hv[j].x + dt * xv * Bn0; hn.y = dA * hv[j].y + dt * xv * Bn1;
            { f32x2v t_; t_[0] = hn.x; t_[1] = hn.y; __builtin_nontemporal_store(t_, (f32x2v*)(p.out + OFF_S_SSM + sbase + (size_t)j * 128)); }
            const float y = wave_sum(hn.x * Cn0 + hn.y * Cn1);
            if (lane == 0) F[512 + rr] = y; }
    }
    __syncthreads();
    if (tid < 256) { const int hh = tid >> 6, h = g * 4 + hh, pp = tid & 63;
        const float z = bf2f(proj[pidx(row, Z_OFF + h * 64 + pp)]);
        F[512 + tid] = (F[512 + tid] + p.Dskip[h] * F[hh * 64 + pp]) * silu(z); }
    __syncthreads();
    {
        const float v = tid < 256 ? F[512 + tid] : 0.f;
        const float s2 = wave_sum(v * v);
        if (lane == 0) F[768 + wid] = s2;
    }
    __syncthreads();
    if (tid < 256) {
        const float tot = F[768] + F[769] + F[770] + F[771];
        const float rs = rsqrtf(tot * (1.f / 256.f) + EPS);
        ((bf16_t*)p.out)[row * 2048 + g * 256 + tid] = f2bf(F[512 + tid] * rs);
    }
}

__device__ void mlstm_sample_unit(const Params& p, LAS unsigned char* lds, int s, int h) {
    int tid_ = threadIdx.x; asm volatile("" : "+v"(tid_));
    const int tid = tid_, lane = tid & 63, wid = __builtin_amdgcn_readfirstlane(tid >> 6);
    bf16_t* proj = (bf16_t*)(p.ws + WS_PROJ);
    const float* gates = (const float*)(p.ws + WS_GATES);
    LAS float* F = (LAS float*)lds;
    const size_t row = (size_t)MP + s;
    const int e = tid & 127, qt = tid >> 7;
    const size_t co = ((size_t)s * 8 + h) * 16384 + (size_t)(qt * 32) * 128 + e;
    float cv[32];
#pragma unroll
    for (int dd = 0; dd < 32; ++dd) cv[dd] = __builtin_nontemporal_load(p.st_C + co + (size_t)dd * 128);
    __syncthreads();
    if (tid < 128) {
        const int ch = h * 128 + tid;
        float y = p.l_cb[ch];
#pragma unroll
        for (int j = 0; j < 3; ++j) y += p.st_lconv[((size_t)s * 3 + j) * 1024 + ch] * p.l_cw[j * 1024 + ch];
        y += p.out[OFF_S_LCONV + ((size_t)s * 3 + 2) * 1024 + ch] * p.l_cw[3 * 1024 + ch];
        F[tid] = silu(y);
        F[128 + tid] = bf2f(proj[pidx(row, V_OFF + ch)]);
    }
    if (tid == 0) {
        const float ig = gates[row * 64 + 32 + h] + p.i_b[h];
        const float lf = logsigm(gates[row * 64 + 40 + h] + p.f_b[h]);
        const float m0 = p.st_m[s * 8 + h];
        const float mn = fmaxf(lf + m0, ig);
        F[1544] = __expf(lf + m0 - mn); F[1545] = __expf(ig - mn); F[1546] = mn;
        p.out[OFF_S_M + s * 8 + h] = mn;
    }
    __syncthreads();
    {
        float aq = 0.f, ak = 0.f;
        const float* wqp = p.wq + (size_t)h * 16384 + e; const float* wkp = p.wk + (size_t)h * 16384 + e;
#pragma unroll 16
        for (int dd = 0; dd < 32; ++dd) { const int d = qt * 32 + dd; const float u = F[d]; aq += u * wqp[d * 128]; ak += u * wkp[d * 128]; }
        F[512 + qt * 128 + e] = aq; F[1024 + qt * 128 + e] = ak;
    }
    __syncthreads();
    if (tid < 128) {
        F[256 + tid] = F[512 + tid] + F[640 + tid] + F[768 + tid] + F[896 + tid];
        F[384 + tid] = (F[1024 + tid] + F[1152 + tid] + F[1280 + tid] + F[1408 + tid]) * 0.08838834764831845f;
    }
    __syncthreads();
    const float fg = F[1544], ig = F[1545], mn = F[1546];
    {
        const float ve = F[128 + e];
        float num = 0.f;
#pragma unroll
        for (int dd = 0; dd < 32; ++dd) {
            const int d = qt * 32 + dd;
            const float cn = fg * cv[dd] + ig * F[384 + d] * ve;
            __builtin_nontemporal_store(cn, p.out + OFF_S_C + co + (size_t)dd * 128);
            num += F[256 + d] * cn;
        }
        __syncthreads();
        F[512 + qt * 128 + e] = num;
    }
    float dpart = 0.f;
    if (tid < 128) {
        const size_t no = ((size_t)s * 8 + h) * 128 + tid;
        const float nn = fg * p.st_n[no] + ig * F[384 + tid];
        p.out[OFF_S_N + no] = nn;
        dpart = F[256 + tid] * nn;
    }
    dpart = wave_sum(dpart);
    if (lane == 0) F[1536 + wid] = dpart;
    __syncthreads();
    float hv = 0.f;
    if (tid < 128) {
        const float den = F[1536] + F[1537];
        const float num = F[512 + tid] + F[640 + tid] + F[768 + tid] + F[896 + tid];
        hv = num / fmaxf(fabsf(den), __expf(-mn));
    }
    const float s2 = wave_sum(hv * hv);
    __syncthreads();
    if (lane == 0) F[1536 + wid] = s2;
    __syncthreads();
    if (tid < 128) {
        const float rs = rsqrtf((F[1536] + F[1537]) * (1.f / 128.f) + EPS);
        const size_t ga = pidx(row, O_OFF + h * 128 + tid);
        ((bf16_t*)(p.ws + WS_XN))[row * 1024 + h * 128 + tid] = f2bf(hv * rs * p.l_nw[h * 128 + tid] * sigm(bf2f(proj[ga])));
    }
}

__device__ void phase_scan(const Params& p, LAS unsigned char* lds, int mask) {
    const int nb = gridDim.x, blk = blockIdx.x;
    if (mask & 1) for (int u = blk; u < 64; u += nb) mlstm_unit(p, lds, u >> 3, u & 7);
    if (mask & 2) {
    if (nb > 64) { if (blk >= 64) for (int u = blk - 64; u < 256; u += nb - 64) ssd_unit(p, lds, u >> 5, u & 31); }
    else for (int u = blk; u < 256; u += nb) ssd_unit(p, lds, u >> 5, u & 31);
    }
    if (!(mask & 4)) return;
    int s0 = blk, sstep = nb;
    if (nb > 128) { if (blk < 128) return; s0 = blk - 128; sstep = nb - 128; }
    for (int u = s0; u < 2048; u += sstep) {
        if (u < 1024) ssd_sample_unit(p, lds, u >> 3, u & 7);
        else mlstm_sample_unit(p, lds, (u - 1024) >> 3, (u - 1024) & 7);
    }
}


template <class Epi>
__device__ __forceinline__ void small_gemm(LAS unsigned char* lds, const bf16_t* A, int lda, const bf16_t* Bt, int K, int N, const Epi& e) {
    int tid_ = threadIdx.x; asm volatile("" : "+v"(tid_));
    const int tid = tid_, lane = tid & 63, wid = __builtin_amdgcn_readfirstlane(tid >> 6), l15 = lane & 15, lq = lane >> 4;
    const int half = wid >> 2, kq = wid & 3, kper = K >> 2;
    LAS float* red = (LAS float*)lds;
    const int npairs = 4 * (N >> 4);
    for (int pr = blockIdx.x; pr < npairs; pr += gridDim.x) {
        const int tile = pr * 2 + half, rb = tile & 7, cb = tile >> 3;
        const bf16_t* ap = A + (size_t)(rb * 16 + l15) * lda + kq * kper + 8 * lq;
        const bf16_t* bp = Bt + (size_t)(cb * 16 + l15) * K + kq * kper + 8 * lq;
        f32x4 acc = (f32x4){0.f, 0.f, 0.f, 0.f};
#pragma unroll 8
        for (int k = 0; k < kper; k += 32) acc = MFMA16(*(const bf16x8*)(ap + k), *(const bf16x8*)(bp + k), acc);
        __syncthreads();
#pragma unroll
        for (int i = 0; i < 4; ++i) red[(wid * 4 + i) * 64 + lane] = acc[i];
        __syncthreads();
        if (kq == 0) {
#pragma unroll
            for (int i = 0; i < 4; ++i) {
                const float v = red[((half * 4 + 0) * 4 + i) * 64 + lane] + red[((half * 4 + 1) * 4 + i) * 64 + lane] + red[((half * 4 + 2) * 4 + i) * 64 + lane] + red[((half * 4 + 3) * 4 + i) * 64 + lane];
                e(rb * 16 + lq * 4 + i, cb * 16 + l15, v);
            }
        }
    }
    __syncthreads();
}
__device__ void phase_norm_ya(const Params& p) {
    bf16_t* ya = (bf16_t*)p.out;
    const float* gssq = (const float*)(p.ws + WS_GSSQ);
    int tid_ = threadIdx.x; asm volatile("" : "+v"(tid_));
    const int tid = tid_;
    const int c = (tid & 255) * 8, g = c >> 8;
    const f32x4 n0 = *(const f32x4*)(p.m_nw + c), n1 = *(const f32x4*)(p.m_nw + c + 4);
    const int rstep = gridDim.x * 2;
    for (int row0 = blockIdx.x * 2 + (tid >> 8); row0 < MP; row0 += 4 * rstep) {
        f32x4 q[4]; u32x4 w[4];
#pragma unroll
        for (int k = 0; k < 4; ++k) { const int row = row0 + k * rstep; if (row < MP) { q[k] = *(const f32x4*)(gssq + (size_t)row * 32 + g * 4); w[k] = *(const u32x4*)(ya + (size_t)row * 2048 + c); } }
#pragma unroll
        for (int k = 0; k < 4; ++k) { const int row = row0 + k * rstep; if (row < MP) {
            const float rs = rsqrtf(((q[k][0] + q[k][1]) + (q[k][2] + q[k][3])) * (1.f / 256.f) + EPS);
            u32x4 o;
            o.x = cvt_pk_bf16(bflo(w[k].x) * rs * n0[0], bfhi(w[k].x) * rs * n0[1]); o.y = cvt_pk_bf16(bflo(w[k].y) * rs * n0[2], bfhi(w[k].y) * rs * n0[3]);
            o.z = cvt_pk_bf16(bflo(w[k].z) * rs * n1[0], bfhi(w[k].z) * rs * n1[1]); o.w = cvt_pk_bf16(bflo(w[k].w) * rs * n1[2], bfhi(w[k].w) * rs * n1[3]);
            *(u32x4*)(ya + (size_t)row * 2048 + c) = o; } }
    }
}
__device__ void phase_h2(const Params& p) {
    const float* ssq = (const float*)(p.ws + WS_SSQ);
    bf16_t* h2 = (bf16_t*)(p.ws + WS_XN);
    int tid_ = threadIdx.x; asm volatile("" : "+v"(tid_));
    const int tid = tid_, lane = tid & 63, wid = __builtin_amdgcn_readfirstlane(tid >> 6);
    const int rstep = gridDim.x * 8;
    f32x4 ww[4];
#pragma unroll
    for (int j = 0; j < 4; ++j) ww[j] = *(const f32x4*)(p.nmlp + lane * 4 + 256 * j);
    for (int row0 = MP + blockIdx.x * 8 + wid; row0 < MR; row0 += 2 * rstep) {
        f32x4 v[2][4]; float sp[2];
#pragma unroll
        for (int k = 0; k < 2; ++k) { const int row = row0 + k * rstep; if (row < MR) {
            sp[k] = (lane < 16 && row < MP) ? ssq[(size_t)row * 16 + lane] : 0.f;
#pragma unroll
            for (int j = 0; j < 4; ++j) v[k][j] = *(const f32x4*)(p.out + (size_t)row * 1024 + lane * 4 + 256 * j); } }
#pragma unroll
        for (int k = 0; k < 2; ++k) { const int row = row0 + k * rstep; if (row < MR) {
            float s = sp[k];
            if (row >= MP) { s = 0.f;
#pragma unroll
                for (int j = 0; j < 4; ++j) s += (v[k][j][0] * v[k][j][0] + v[k][j][1] * v[k][j][1]) + (v[k][j][2] * v[k][j][2] + v[k][j][3] * v[k][j][3]); }
            const float rs = rsqrtf(wave_sum(s) * (1.f / 1024.f) + EPS);
#pragma unroll
            for (int j = 0; j < 4; ++j) { u32x2 o; o.x = cvt_pk_bf16(v[k][j][0] * rs * ww[j][0], v[k][j][1] * rs * ww[j][1]); o.y = cvt_pk_bf16(v[k][j][2] * rs * ww[j][2], v[k][j][3] * rs * ww[j][3]);
                *(u32x2*)(h2 + (size_t)row * 1024 + lane * 4 + 256 * j) = o; } } }
    }
}
__device__ void phase_final(const Params& p) {
    const float* ssq = (const float*)(p.ws + WS_SSQ);
    int tid_ = threadIdx.x; asm volatile("" : "+v"(tid_));
    const int tid = tid_, lane = tid & 63, wid = __builtin_amdgcn_readfirstlane(tid >> 6);
    const int rstep = gridDim.x * 8;
    f32x4 ww[4];
#pragma unroll
    for (int j = 0; j < 4; ++j) ww[j] = *(const f32x4*)(p.fnw + lane * 4 + 256 * j);
    for (int row0 = MP + blockIdx.x * 8 + wid; row0 < MR; row0 += 2 * rstep) {
        f32x4 v[2][4]; float sp[2];
#pragma unroll
        for (int k = 0; k < 2; ++k) { const int row = row0 + k * rstep; if (row < MR) {
            sp[k] = (lane < 16 && row < MP) ? ssq[(size_t)row * 16 + lane] : 0.f;
#pragma unroll
            for (int j = 0; j < 4; ++j) v[k][j] = *(const f32x4*)(p.out + (size_t)row * 1024 + lane * 4 + 256 * j); } }
#pragma unroll
        for (int k = 0; k < 2; ++k) { const int row = row0 + k * rstep; if (row < MR) {
            float s = sp[k];
            if (row >= MP) { s = 0.f;
#pragma unroll
                for (int j = 0; j < 4; ++j) s += (v[k][j][0] * v[k][j][0] + v[k][j][1] * v[k][j][1]) + (v[k][j][2] * v[k][j][2] + v[k][j][3] * v[k][j][3]); }
            const float rs = rsqrtf(wave_sum(s) * (1.f / 1024.f) + EPS);
#pragma unroll
            for (int j = 0; j < 4; ++j) *(f32x4*)(p.out + (size_t)row * 1024 + lane * 4 + 256 * j) = v[k][j] * rs * ww[j]; } }
    }
}

#define XB_TMO      128
#define XB_XCNT(j)  (256  + 64 * (j))
#define XB_XSUB(j)  (1280 + 64 * (j))
#define XB_XGEN(j)  (2304 + 64 * (j))
#define XB_TOP      3328
#define XB_TOPGEN   3392
#define XB_SPIN_CAP (1u << 20)
__device__ __forceinline__ unsigned xb_ld(unsigned* p)              { return __hip_atomic_load(p, __ATOMIC_RELAXED, __HIP_MEMORY_SCOPE_AGENT); }
__device__ __forceinline__ unsigned xb_add(unsigned* p, unsigned v) { return __hip_atomic_fetch_add(p, v, __ATOMIC_RELAXED, __HIP_MEMORY_SCOPE_AGENT); }
__device__ __forceinline__ unsigned xb_xcc_id() { return (unsigned)__builtin_amdgcn_s_getreg((3 << 11) | 20) & 0xFu; }
#define XB_SPIN(cond, bar) do { unsigned _sp = 0; while (cond) { __builtin_amdgcn_s_sleep(1); \
    if ((++_sp & 255u) == 0u) { if (xb_ld(&(bar)[XB_TMO])) break; if (_sp > XB_SPIN_CAP) { atomicAdd(&(bar)[XB_TMO], 1u); break; } } } } while (0)
__device__ __forceinline__ void xb_complete(unsigned* bar, unsigned x, unsigned& nloc, unsigned& nx) {
    const unsigned G = gridDim.x;
    unsigned sum, cnt, mine, sp = 0u;
    for (;;) {
        sum = 0u; cnt = 0u; mine = 0u;
#pragma unroll
        for (unsigned j = 0; j < 16; ++j) { const unsigned c = xb_ld(&bar[XB_XCNT(j)]); sum += c; cnt += (c > 0u) ? 1u : 0u; mine = (j == x) ? c : mine; }
        if (sum == G) break;
        __builtin_amdgcn_s_sleep(1);
        if ((++sp & 255u) == 0u) { if (xb_ld(&bar[XB_TMO])) break; if (sp > XB_SPIN_CAP) { atomicAdd(&bar[XB_TMO], 1u); break; } }
    }
    nloc = mine > 0u ? mine : 1u; nx = cnt > 0u ? cnt : 1u;
}
constexpr int LDS_XB = 155648 - 16;
__device__ __forceinline__ void gsync(unsigned* bar, LAS unsigned char* lds) {
    asm volatile("s_waitcnt vmcnt(0) lgkmcnt(0)" ::: "memory");
    __syncthreads();
    if (threadIdx.x == 0) {
        volatile LAS unsigned* st = (volatile LAS unsigned*)(lds + LDS_XB);
        const unsigned x = xb_xcc_id();
        unsigned nloc = st[0], nx = st[1];
        if (nloc == 0u) { xb_complete(bar, x, nloc, nx); st[0] = nloc; st[1] = nx; }
        const unsigned old = xb_add(&bar[XB_XSUB(x)], 1u);
        const unsigned gen = old / nloc;
        if (old + 1u == (gen + 1u) * nloc) {
            __builtin_amdgcn_fence(__ATOMIC_RELEASE, "agent");
            asm volatile("s_waitcnt vmcnt(0)" ::: "memory");
            const unsigned og = xb_add(&bar[XB_TOP], 1u);
            const unsigned tg = og / nx;
            if (og + 1u == (tg + 1u) * nx) xb_add(&bar[XB_TOPGEN], 1u);
            else XB_SPIN(xb_ld(&bar[XB_TOPGEN]) == tg, bar);
            __builtin_amdgcn_fence(__ATOMIC_ACQUIRE, "agent");
            xb_add(&bar[XB_XGEN(x)], 1u);
            asm volatile("s_waitcnt vmcnt(0)" ::: "memory");
        } else {
            XB_SPIN(xb_ld(&bar[XB_XGEN(x)]) == gen, bar);
            __builtin_amdgcn_fence(__ATOMIC_ACQUIRE, "agent");
            asm volatile("s_waitcnt vmcnt(0)" ::: "memory");
        }
    }
    __syncthreads();
}
constexpr int LDS_BYTES = 155648;
typedef const __attribute__((address_space(4))) Params* KargPtr;
__device__ __forceinline__ Params load_params() {
#if defined(__HIP_DEVICE_COMPILE__)
    KargPtr kp = (KargPtr)__builtin_amdgcn_kernarg_segment_ptr();
    asm volatile("" : "+s"(kp));
    return *kp;
#else
    return Params{};
#endif
}
__global__ void __launch_bounds__(512) fwd_megakernel(Params p_arg) {
    extern __shared__ __attribute__((aligned(16))) unsigned char lds_raw[];
    LAS unsigned char* lds = (LAS unsigned char*)lds_raw;
    cg::grid_group grid = cg::this_grid();
    unsigned* gbar;
    { const Params p = load_params(); gbar = (unsigned*)(p.ws + WS_BAR); if (__builtin_expect(p.ws == nullptr, 0)) grid.sync(); }
    if (threadIdx.x == 0) {
        volatile LAS unsigned* st = (volatile LAS unsigned*)(lds + LDS_XB); st[0] = 0u; st[1] = 0u;
        (void)xb_add(&gbar[XB_XCNT(xb_xcc_id())], 1u);
    }
    __syncthreads();
    pg8::StaticOrder S;

    { const Params p = load_params(); phase_prep(p, lds); }
    gsync(gbar, lds);
    {
        const Params p = load_params(); unsigned char* ws = p.ws;
        S.init(MPAD, LDP, gridDim.x, blockIdx.x);
        EpiProj E{(bf16_t*)(ws + WS_PROJ), (float*)(ws + WS_GATES), p.out};
        pg8::gemm_phase(lds, (const bf16_t*)(ws + WS_XN), 1024, (const bf16_t*)(ws + WS_WIN), 1024, S, E);
    }
    gsync(gbar, lds);
    { const Params p = load_params(); phase_scan(p, lds, 7); }
    gsync(gbar, lds);
    {
        const Params p = load_params(); unsigned char* ws = p.ws;
        bf16_t* proj = (bf16_t*)(ws + WS_PROJ);
        S.init(MP, 1024, gridDim.x, blockIdx.x);
        {
            Unit u0; LAS float* rho = (LAS float*)(lds + L_RHO);
            if (S.next(0, u0) && threadIdx.x < 256) {
                const float* gq = (const float*)(ws + WS_GSSQ) + (size_t)(u0.pm * 256 + threadIdx.x) * 32; float rs[8];
#pragma unroll
                for (int g = 0; g < 8; ++g) { const f32x4 q = *(const f32x4*)(gq + g * 4); rs[g] = rsqrtf(((q[0] + q[1]) + (q[2] + q[3])) * (1.f / 256.f) + EPS); }
                rho[threadIdx.x * 8] = rs[7];
#pragma unroll
                for (int g = 1; g < 8; ++g) rho[threadIdx.x * 8 + g] = rs[g - 1] * __builtin_amdgcn_rcpf(rs[g]);
            }
            __syncthreads();
        }
        EpiGateAS EA{proj, lds};
        pg8::gemm_phase(lds, (const bf16_t*)p.out, 2048, (const bf16_t*)(ws + WS_WA), 2048, S, EA);
        __syncthreads();
        EpiGateB EB{proj, (bf16_t*)(ws + WS_MRG)};
        pg8::gemm_phase(lds, (const bf16_t*)(ws + WS_XN), 1024, (const bf16_t*)(ws + WS_WB), 1024, S, EB);
        __syncthreads();
        bf16_t* tmpS = proj + (size_t)(XBC_OFF / 64) * MPAD * 64 + (size_t)MP * 1024;
        bf16_t* mrgS = (bf16_t*)(ws + WS_MRG) + (size_t)MP * 1024;
        small_gemm(lds, (const bf16_t*)p.out + (size_t)MP * 2048, 2048, (const bf16_t*)(ws + WS_WA), 2048, 1024,
                   [=](int r, int c, float v) { tmpS[r * 1024 + c] = f2bf(sigm(bf2f(proj[pidx(MP + r, GA_OFF + c)])) * v); });
        small_gemm(lds, (const bf16_t*)(ws + WS_XN) + (size_t)MP * 1024, 1024, (const bf16_t*)(ws + WS_WB), 1024, 1024,
                   [=](int r, int c, float v) { mrgS[r * 1024 + c] = f2bf(bf2f(tmpS[r * 1024 + c]) + sigm(bf2f(proj[pidx(MP + r, GB_OFF + c)])) * v); });
    }
    gsync(gbar, lds);
    {
        const Params p = load_params(); unsigned char* ws = p.ws;
        S.init(MP, 1024, gridDim.x, blockIdx.x);
        EpiResidNormH2 E{p.x_prompt, p.out, (bf16_t*)(ws + WS_XN), p.nmlp, (float*)(ws + WS_PX), (unsigned*)(ws + WS_PCNT + 16384)};
        pg8::gemm_phase(lds, (const bf16_t*)(ws + WS_MRG), 1024, (const bf16_t*)(ws + WS_WO), 1024, S, E);
        __syncthreads();
        const float* xs = p.x_sample; float* xo = p.out + (size_t)MP * 1024;
        small_gemm(lds, (const bf16_t*)(ws + WS_MRG) + (size_t)MP * 1024, 1024, (const bf16_t*)(ws + WS_WO), 1024, 1024,
                   [=](int r, int c, float v) { xo[r * 1024 + c] = xs[r * 1024 + c] + v; });
    }
    gsync(gbar, lds);
    { const Params p = load_params(); phase_h2(p); }
    gsync(gbar, lds);
    {
        const Params p = load_params(); unsigned char* ws = p.ws;
        S.init(MP, DFF, gridDim.x, blockIdx.x);
        EpiUp E{(bf16_t*)(ws + WS_PROJ)};
        pg8::gemm_phase(lds, (const bf16_t*)(ws + WS_XN), 1024, (const bf16_t*)(ws + WS_WUP), 1024, S, E);
        __syncthreads();
        bf16_t* upS = (bf16_t*)(ws + WS_PROJ) + (size_t)MP * DFF;
        small_gemm(lds, (const bf16_t*)(ws + WS_XN) + (size_t)MP * 1024, 1024, (const bf16_t*)(ws + WS_WUP), 1024, DFF,
                   [=](int r, int c, float v) { const float a = fmaxf(v, 0.f); upS[r * DFF + c] = f2bf(a * a); });
    }
    gsync(gbar, lds);
    {
        const Params p = load_params(); unsigned char* ws = p.ws;
        S.init(MP, 1024, gridDim.x, blockIdx.x);
        EpiResidNorm E{p.out, p.fnw, (float*)(ws + WS_PX), (unsigned*)(ws + WS_PCNT)};
        pg8::gemm_phase(lds, (const bf16_t*)(ws + WS_PROJ), DFF, (const bf16_t*)(ws + WS_WDN), DFF, S, E);
        __syncthreads();
        float* xo = p.out + (size_t)MP * 1024;
        small_gemm(lds, (const bf16_t*)(ws + WS_PROJ) + (size_t)MP * DFF, DFF, (const bf16_t*)(ws + WS_WDN), DFF, 1024,
                   [=](int r, int c, float v) { xo[r * 1024 + c] += v; });
    }
    gsync(gbar, lds);
    { const Params p = load_params(); phase_final(p); }
}

extern "C" void kernel_launch(void* const* d_in, const int* in_sizes, int n_in, void* d_out, int out_size, void* d_ws, size_t ws_size, hipStream_t stream) {
    static int grid_blocks = 0;
    if (grid_blocks == 0) {
        if (ws_size < WS_END) { fprintf(stderr, "kernel_launch: workspace too small: %zu < %zu\n", ws_size, (size_t)WS_END); grid_blocks = -1; return; }
        int dev = 0, cus = 0, per_cu = 0;
        hipGetDevice(&dev);
        hipDeviceGetAttribute(&cus, hipDeviceAttributeMultiprocessorCount, dev);
        if (hipFuncSetAttribute((const void*)fwd_megakernel, hipFuncAttributeMaxDynamicSharedMemorySize, LDS_BYTES) != hipSuccess) { fprintf(stderr, "kernel_launch: hipFuncSetAttribute failed\n"); }
        hipOccupancyMaxActiveBlocksPerMultiprocessor(&per_cu, (const void*)fwd_megakernel, 512, LDS_BYTES);
        (void)hipGetLastError();
        if (per_cu < 1) per_cu = 1;
        grid_blocks = cus;
    }
    if (grid_blocks < 0) return;
    Params p{};
    const float** f = (const float**)&p;
    for (int i = 0; i < 30; ++i) f[i] = (const float*)d_in[i];
    p.out = (float*)d_out; p.ws = (unsigned char*)d_ws;
    (void)hipMemsetAsync((unsigned char*)d_ws + WS_BAR, 0, 49152, stream);
    void* args[] = {&p};
    hipError_t e = hipLaunchCooperativeKernel((const void*)fwd_megakernel, dim3(grid_blocks), dim3(512), args, LDS_BYTES, stream);
    if (e != hipSuccess) fprintf(stderr, "cooperative launch failed: %s (grid %d)\n", hipGetErrorString(e), grid_blocks);
}
```
